# Optimizing an MI355X kernel written in HIP

```python
import jax, jax.numpy as jnp
from jax import lax
import numpy as np

D_MODEL = 1024
BATCH = 16
SEQ = 2048
DEPTH = 1

CTX_LEN = 256
GRID_W = 64
EPS = 1e-6

M_HEADS = 8
M_HEAD_DIM = 128
M_WIDTH = M_HEADS * M_HEAD_DIM
M_CHUNK = 64
M_INIT = -1e30

A_HEADS = 8
A_KV_HEADS = 2
A_GROUP = A_HEADS // A_KV_HEADS
A_HEAD_DIM = 128
A_Q_WIDTH = A_HEADS * A_HEAD_DIM
A_KV_WIDTH = A_KV_HEADS * A_HEAD_DIM
Q_BLOCK = 128
ROPE_THETA = 10000.0

N_BRANCH = 2

N_GROUPS = 4
EXPERTS_PER_GROUP = 8
N_EXPERTS = N_GROUPS * EXPERTS_PER_GROUP
TOP_K = 2
D_EXPERT = 256

SPLITS = (M_WIDTH, M_WIDTH, M_WIDTH, M_WIDTH, 4 * M_HEADS, A_Q_WIDTH, A_KV_WIDTH, A_KV_WIDTH, N_BRANCH * D_MODEL)
IN_WIDTH = 4 * M_WIDTH + 4 * M_HEADS + A_Q_WIDTH + 2 * A_KV_WIDTH + N_BRANCH * D_MODEL

kernel_name = "hybrid_mlstm_gqa_hmoe_dit_layer"


def rms(x, w=None):
    xf = x.astype(jnp.float32)
    y = (xf * lax.rsqrt(jnp.mean(xf * xf, axis=-1, keepdims=True) + EPS)).astype(x.dtype)
    return y if w is None else y * w


def ada_mod(cvec, w, b):
    mod = jax.nn.silu(cvec) @ w + b
    return jnp.split(mod[..., None, :], 6, axis=-1)


def modulate(xn, shift, scale):
    return xn * (1.0 + scale) + shift


def split_proj(p):
    points = [int(s) for s in np.cumsum(SPLITS)[:-1]]
    return jnp.split(p, points, axis=-1)


def axial_rope_tables(n_tokens):
    rows = n_tokens // GRID_W
    row = jnp.repeat(jnp.arange(rows), GRID_W).astype(jnp.float32)
    col = jnp.tile(jnp.arange(GRID_W), rows).astype(jnp.float32)
    half = A_HEAD_DIM // 2
    inv = ROPE_THETA ** (-jnp.arange(0, half, 2, dtype=jnp.float32) / half)
    ang_r = row[:, None] * inv[None, :]
    ang_c = col[:, None] * inv[None, :]
    return (jnp.cos(ang_r), jnp.sin(ang_r), jnp.cos(ang_c), jnp.sin(ang_c))


def rope_axis(x, cos, sin):
    d = x.shape[-1] // 2
    x1, x2 = x[..., :d], x[..., d:]
    return jnp.concatenate([x1 * cos - x2 * sin, x2 * cos + x1 * sin], axis=-1)


def apply_axial_rope(x, tabs):
    cr, sr, cc, sc = tabs
    half = A_HEAD_DIM // 2
    y = jnp.concatenate([rope_axis(x[..., :half], cr, sr), rope_axis(x[..., half:], cc, sc)], axis=-1)
    return y.astype(x.dtype)


def flip(t):
    return jnp.flip(t, axis=2)


def mlstm_inputs(p, b_gate):
    mq, mk, mv, mg = p[0], p[1], p[2], p[4]
    B, L, _ = mq.shape

    def to_heads(t):
        return t.reshape(B, L, M_HEADS, M_HEAD_DIM).transpose(0, 2, 1, 3).astype(jnp.float32)

    g = (mg.astype(jnp.float32) + b_gate.astype(jnp.float32)).reshape(B, L, 4, M_HEADS).transpose(2, 0, 3, 1)
    fwd = (g[0], jax.nn.log_sigmoid(g[1]))
    bwd = (g[2], jax.nn.log_sigmoid(g[3]))
    return to_heads(mq), to_heads(mk), to_heads(mv), fwd, bwd


def mlstm_init(B):
    return (jnp.zeros((B, M_HEADS, M_HEAD_DIM, M_HEAD_DIM), jnp.float32),
            jnp.zeros((B, M_HEADS, M_HEAD_DIM), jnp.float32),
            jnp.full((B, M_HEADS), M_INIT, jnp.float32))


def mlstm_scan(q, k, v, i_pre, logf, state):
    B, H, L, dh = q.shape
    nc = L // M_CHUNK

    def to_chunks(a):
        a = a.reshape(B, H, nc, M_CHUNK, *a.shape[3:])
        return jnp.moveaxis(a, 2, 0)

    xs = (to_chunks(q * (dh ** -0.5)), to_chunks(k), to_chunks(v), to_chunks(i_pre), to_chunks(logf))
    lower = jnp.tril(jnp.ones((M_CHUNK, M_CHUNK), dtype=bool))

    def step(carry, chunk):
        C, n, m = carry
        qc, kc, vc, ic, fc = chunk
        b = jnp.cumsum(fc, axis=-1)
        dmat = jnp.where(lower, b[..., :, None] - b[..., None, :] + ic[..., None, :], -jnp.inf)
        inter = b + m[..., None]
        m_q = jnp.maximum(inter, jnp.max(dmat, axis=-1))
        w_intra = jnp.exp(dmat - m_q[..., None])
        w_inter = jnp.exp(inter - m_q)
        s = jnp.einsum('bhsd,bhrd->bhsr', qc, kc) * w_intra
        num = w_inter[..., None] * jnp.einsum('bhsd,bhde->bhse', qc, C) + jnp.einsum('bhsr,bhre->bhse', s, vc)
        den = w_inter * jnp.einsum('bhsd,bhd->bhs', qc, n) + jnp.sum(s, axis=-1)
        h = num / jnp.maximum(jnp.abs(den), jnp.exp(-m_q))[..., None]
        b_last = b[..., -1]
        dec_in = b_last[..., None] - b + ic
        m_new = jnp.maximum(b_last + m, jnp.max(dec_in, axis=-1))
        w_old = jnp.exp(b_last + m - m_new)
        w_in = jnp.exp(dec_in - m_new[..., None])
        C_new = w_old[..., None, None] * C + jnp.einsum('bhr,bhrd,bhre->bhde', w_in, kc, vc)
        n_new = w_old[..., None] * n + jnp.einsum('bhr,bhrd->bhd', w_in, kc)
        return (C_new, n_new, m_new), h

    final, hs = lax.scan(step, state, xs)
    h = jnp.moveaxis(hs, 0, 2).reshape(B, H, L, dh)
    return h, final


def attn_inputs(p, q_norm_w, k_norm_w):
    aq, ak, av = p[5], p[6], p[7]
    B, L, _ = aq.shape
    q = rms(aq.reshape(B, L, A_KV_HEADS, A_GROUP, A_HEAD_DIM), q_norm_w).transpose(0, 2, 3, 1, 4)
    k = rms(ak.reshape(B, L, A_KV_HEADS, A_HEAD_DIM), k_norm_w).transpose(0, 2, 1, 3)
    v = av.reshape(B, L, A_KV_HEADS, A_HEAD_DIM).transpose(0, 2, 1, 3)
    return q, k, v


def block_attention(q, k, v):
    B, Hk, G, Lq, dh = q.shape
    nb = Lq // Q_BLOCK
    qb = jnp.moveaxis(q.reshape(B, Hk, G, nb, Q_BLOCK, dh), 3, 0)
    scale = dh ** -0.5

    def attend(qblk):
        s = jnp.einsum('bkgqd,bksd->bkgqs', qblk, k).astype(jnp.float32) * scale
        pr = jax.nn.softmax(s, axis=-1).astype(v.dtype)
        return jnp.einsum('bkgqs,bksd->bkgqd', pr, v)

    o = lax.map(attend, qb)
    o = jnp.moveaxis(o, 0, 3).reshape(B, Hk, G, Lq, dh)
    return o.transpose(0, 3, 1, 2, 4).reshape(B, Lq, A_Q_WIDTH)


def merge_branches(p, h_m, o_attn, mh_norm_w, w_bm, w_ba, w_o):
    dtype = o_attn.dtype
    B, L, _ = o_attn.shape
    hm = rms(h_m.transpose(0, 2, 1, 3)).reshape(B, L, M_WIDTH).astype(dtype) * mh_norm_w
    y_m = (jax.nn.sigmoid(p[3]) * hm) @ w_bm
    y_a = o_attn @ w_ba
    g = jax.nn.sigmoid(p[8]).reshape(B, L, N_BRANCH, D_MODEL)
    return (g[:, :, 0] * y_m + g[:, :, 1] * y_a) @ w_o


def hier_moe(h, w_rg, b_rg, w_re, b_re, w_g, w_u, w_d):
    B, L, D = h.shape
    hf = h.reshape(B * L, D)
    g_logits = (hf @ w_rg).astype(jnp.float32) + b_rg.astype(jnp.float32)
    g_sel = jnp.argmax(g_logits, axis=-1)
    p_grp = jnp.max(jax.nn.softmax(g_logits, axis=-1), axis=-1, keepdims=True)
    e_logits = ((hf @ w_re).astype(jnp.float32) + b_re.astype(jnp.float32)).reshape(-1, N_GROUPS, EXPERTS_PER_GROUP)
    e_grp = jnp.einsum('nge,ng->ne', e_logits, jax.nn.one_hot(g_sel, N_GROUPS, dtype=jnp.float32))
    top_v, top_i = lax.top_k(e_grp, TOP_K)
    w_top = jax.nn.softmax(top_v, axis=-1) * p_grp
    eid = g_sel[:, None] * EXPERTS_PER_GROUP + top_i
    combine = jnp.einsum('nk,nke->ne', w_top, jax.nn.one_hot(eid, N_EXPERTS, dtype=jnp.float32)).astype(h.dtype)

    def expert(acc, xs):
        wg, wu, wd, col = xs
        y = (jax.nn.silu(hf @ wg) * (hf @ wu)) @ wd
        return acc + col[:, None] * y, None

    out, _ = lax.scan(expert, jnp.zeros_like(hf), (w_g, w_u, w_d, combine.T))
    return out.reshape(B, L, D)


def setup_inputs(seed: int = 0) -> dict:
    key = jax.random.key(seed)
    ks = jax.random.split(key, 23)
    D = D_MODEL

    def nrm(k, shape, scale):
        return jax.random.normal(k, shape, jnp.float32) * scale

    f_base = jnp.linspace(3.0, 6.0, M_HEADS, dtype=jnp.float32)
    gate_base = jnp.stack([jnp.zeros_like(f_base), f_base, jnp.zeros_like(f_base), f_base]).reshape(-1)
    return {
        "x": nrm(ks[0], (BATCH, SEQ, D), 1.0),
        "c": nrm(ks[1], (BATCH, D), 1.0),
        "ctx": nrm(ks[2], (BATCH, CTX_LEN, D), 1.0),
        "c_ctx": nrm(ks[3], (D,), 1.0),
        "w_ada": nrm(ks[4], (DEPTH, D, 6 * D), 0.5 * D ** -0.5),
        "b_ada": nrm(ks[5], (DEPTH, 6 * D), 0.02),
        "norm1_w": 1.0 + nrm(ks[6], (DEPTH, D), 0.02),
        "w_in": nrm(ks[7], (DEPTH, D, IN_WIDTH), D ** -0.5),
        "b_mgate": gate_base[None, :] + nrm(ks[8], (DEPTH, 4 * M_HEADS), 0.1),
        "q_norm_w": 1.0 + nrm(ks[9], (DEPTH, A_HEAD_DIM), 0.02),
        "k_norm_w": 1.0 + nrm(ks[10], (DEPTH, A_HEAD_DIM), 0.02),
        "mh_norm_w": 1.0 + nrm(ks[11], (DEPTH, M_WIDTH), 0.02),
        "w_branch_m": nrm(ks[12], (DEPTH, M_WIDTH, D), M_WIDTH ** -0.5),
        "w_branch_a": nrm(ks[13], (DEPTH, A_Q_WIDTH, D), A_Q_WIDTH ** -0.5),
        "w_out": nrm(ks[14], (DEPTH, D, D), D ** -0.5),
        "norm2_w": 1.0 + nrm(ks[15], (DEPTH, D), 0.02),
        "w_rg": nrm(ks[16], (DEPTH, D, N_GROUPS), D ** -0.5),
        "b_rg": nrm(ks[17], (DEPTH, N_GROUPS), 0.01),
        "w_re": nrm(ks[18], (DEPTH, D, N_EXPERTS), D ** -0.5),
        "b_re": nrm(ks[19], (DEPTH, N_EXPERTS), 0.01),
        "w_e_gate": nrm(ks[20], (DEPTH, N_EXPERTS, D, D_EXPERT), D ** -0.5),
        "w_e_up": nrm(ks[21], (DEPTH, N_EXPERTS, D, D_EXPERT), D ** -0.5),
        "w_e_down": nrm(ks[22], (DEPTH, N_EXPERTS, D_EXPERT, D), D_EXPERT ** -0.5),
    }


def reference(x, c, ctx, c_ctx, w_ada, b_ada, norm1_w, w_in, b_mgate, q_norm_w, k_norm_w, mh_norm_w,
              w_branch_m, w_branch_a, w_out, norm2_w, w_rg, b_rg, w_re, b_re, w_e_gate, w_e_up, w_e_down):
    B, L, _ = x.shape
    rope = axial_rope_tables(L)
    h_lat, h_ctx = x, ctx
    for l in range(DEPTH):
        update_ctx = l < DEPTH - 1
        sh1, sc1, g1, sh2, sc2, g2 = ada_mod(c, w_ada[l], b_ada[l])
        csh1, csc1, cg1, csh2, csc2, cg2 = ada_mod(c_ctx, w_ada[l], b_ada[l])

        p_lat = split_proj(modulate(rms(h_lat, norm1_w[l]), sh1, sc1) @ w_in[l])
        p_ctx = split_proj(modulate(rms(h_ctx, norm1_w[l]), csh1, csc1) @ w_in[l])

        init = mlstm_init(B)
        cq, ck, cv, (ci_f, cf_f), (ci_b, cf_b) = mlstm_inputs(p_ctx, b_mgate[l])
        hc_f, st_f = mlstm_scan(cq, ck, cv, ci_f, cf_f, init)
        hc_b, st_b = mlstm_scan(flip(cq), flip(ck), flip(cv), flip(ci_b), flip(cf_b), init)
        lq, lk, lv, (li_f, lf_f), (li_b, lf_b) = mlstm_inputs(p_lat, b_mgate[l])
        hl_f, _ = mlstm_scan(lq, lk, lv, li_f, lf_f, st_f)
        hl_b, _ = mlstm_scan(flip(lq), flip(lk), flip(lv), flip(li_b), flip(lf_b), st_b)
        hm_lat = hl_f + flip(hl_b)

        cq_a, ck_a, cv_a = attn_inputs(p_ctx, q_norm_w[l], k_norm_w[l])
        lq_a, lk_a, lv_a = attn_inputs(p_lat, q_norm_w[l], k_norm_w[l])
        lq_a = apply_axial_rope(lq_a, rope)
        lk_a = apply_axial_rope(lk_a, rope)
        ha_lat = block_attention(lq_a, jnp.concatenate([lk_a, ck_a], axis=2), jnp.concatenate([lv_a, cv_a], axis=2))

        mix_lat = merge_branches(p_lat, hm_lat, ha_lat, mh_norm_w[l], w_branch_m[l], w_branch_a[l], w_out[l])
        h_lat_mid = h_lat + g1 * mix_lat

        if update_ctx:
            hm_ctx = hc_f + flip(hc_b)
            ha_ctx = block_attention(cq_a, ck_a, cv_a)
            mix_ctx = merge_branches(p_ctx, hm_ctx, ha_ctx, mh_norm_w[l], w_branch_m[l], w_branch_a[l], w_out[l])
            h_ctx = h_ctx + cg1 * mix_ctx
            f_ctx = modulate(rms(h_ctx, norm2_w[l]), csh2, csc2)
            h_ctx = h_ctx + cg2 * hier_moe(f_ctx, w_rg[l], b_rg[l], w_re[l], b_re[l], w_e_gate[l], w_e_up[l], w_e_down[l])

        f_lat = modulate(rms(h_lat_mid, norm2_w[l]), sh2, sc2)
        h_lat = h_lat_mid + g2 * hier_moe(f_lat, w_rg[l], b_rg[l], w_re[l], b_re[l], w_e_gate[l], w_e_up[l], w_e_down[l])
    return h_lat
```

```cpp
#include <hip/hip_runtime.h>
#include <cstdio>
#include <cstdint>

#define LAS __attribute__((address_space(3)))
#define GAS __attribute__((address_space(1)))
typedef unsigned short bf16_t;
typedef short bf16x8 __attribute__((ext_vector_type(8)));
typedef short s16x4 __attribute__((ext_vector_type(4)));
typedef float f32x4 __attribute__((ext_vector_type(4)));
typedef float f32x2 __attribute__((ext_vector_type(2)));
typedef float f32x16 __attribute__((ext_vector_type(16)));
typedef unsigned u32x4 __attribute__((ext_vector_type(4)));
typedef unsigned u32x2 __attribute__((ext_vector_type(2)));
typedef GAS unsigned gu32;

constexpr int D = 1024, NB = 16, SEQ = 2048, CTXL = 256;
constexpr int T_LAT = NB * SEQ, T_CTX = NB * CTXL, T_ALL = T_LAT + T_CTX;
constexpr int IN_W = 7712, NMOD = 6 * D;
constexpr int KVL = SEQ + CTXL;
constexpr int NEXP = 32, DEXP = 256;
constexpr float EPS = 1e-6f;
constexpr int NWAVES = 8, NTHREADS = 512;

constexpr int NT_LAT = 31, NT_CTX = 11, NW_IN = NT_LAT * 256;
constexpr int MT_LAT = T_LAT / 256, MT_CTX = T_CTX / 256;

constexpr size_t MiB = 1u << 20;
constexpr size_t WS_CTL = 0, CTL_ZERO_BYTES = 1 * MiB;
constexpr size_t WS_MOD = 1 * MiB;
constexpr size_t WS_ROPE = 1 * MiB + 512 * 1024;
constexpr size_t WS_GATES = 2 * MiB;
constexpr size_t WS_WBM = 7 * MiB, WS_WBA = 9 * MiB, WS_WO = 11 * MiB;
constexpr size_t WS_WIN = 13 * MiB;
constexpr size_t WS_ROUT = 29 * MiB;
constexpr size_t WS_LISTS = 30 * MiB;
constexpr size_t WS_A0 = 38 * MiB;
constexpr size_t WS_MQ = 110 * MiB;
constexpr size_t WS_MK = 174 * MiB;
constexpr size_t WS_MV = 246 * MiB;
constexpr size_t WS_OG = 318 * MiB;
constexpr size_t WS_AQ = 382 * MiB;
constexpr size_t WS_AK = 446 * MiB;
constexpr size_t WS_AV = 464 * MiB;
constexpr size_t WS_END = 482 * MiB;
constexpr size_t WS_WGU = WS_A0, WS_WD = WS_A0 + 32 * MiB;
constexpr size_t WS_Z = WS_MK, WS_FL = WS_MV, WS_H = WS_OG, WS_HTMP = WS_A0;

constexpr int CW_TMO = 0, CW_ATTQ = 64, CW_BAR = 4096;
constexpr int CW_CNT = 8192;
constexpr int LDS_BYTES = 155648;
constexpr int MISC_OFF = 147456;

#define RLX_AGENT __ATOMIC_RELAXED, __HIP_MEMORY_SCOPE_AGENT
#define LDS_WAIT() asm volatile("s_waitcnt lgkmcnt(0)" ::: "memory")
#define VM_WAIT() asm volatile("s_waitcnt vmcnt(0)" ::: "memory")

__device__ __forceinline__ unsigned f2bf(float f) { unsigned u = __builtin_bit_cast(unsigned, f); return (u + 0x7fffu + ((u >> 16) & 1u)) >> 16; }
__device__ __forceinline__ unsigned pk2(float lo, float hi) { return f2bf(lo) | (f2bf(hi) << 16); }
__device__ __forceinline__ float bf2f(unsigned short b) { return __builtin_bit_cast(float, ((unsigned)b) << 16); }
__device__ __forceinline__ float bflo(unsigned w) { return __builtin_bit_cast(float, w << 16); }
__device__ __forceinline__ float bfhi(unsigned w) { return __builtin_bit_cast(float, w & 0xffff0000u); }
__device__ __forceinline__ unsigned cvt_pk_bf16(float lo, float hi) { unsigned r; asm volatile("v_cvt_pk_bf16_f32 %0, %1, %2" : "=v"(r) : "v"(lo), "v"(hi)); return r; }
__device__ __forceinline__ float wave_sum(float v) {
#pragma unroll
    for (int o = 1; o < 64; o <<= 1) v += __shfl_xor(v, o);
    return v;
}
__device__ __forceinline__ float wave_max(float v) {
#pragma unroll
    for (int o = 1; o < 64; o <<= 1) v = fmaxf(v, __shfl_xor(v, o));
    return v;
}
__device__ __forceinline__ float sigmoidf_(float x) { return 1.0f / (1.0f + __expf(-x)); }
__device__ __forceinline__ float siluf_(float x) { return x / (1.0f + __expf(-x)); }

#define XB_TMO      128
#define XB_XCNT(j)  (256  + 64 * (j))
#define XB_XSUB(j)  (1280 + 64 * (j))
#define XB_XGEN(j)  (2304 + 64 * (j))
#define XB_TOP      3328
#define XB_TOPGEN   3392
#define XCD_BAR_WORDS 3456
#define XB_SPIN_CAP (1u << 18)

__device__ __forceinline__ unsigned xb_ld(unsigned* p)              { return __hip_atomic_load(p, __ATOMIC_RELAXED, __HIP_MEMORY_SCOPE_AGENT); }
__device__ __forceinline__ unsigned xb_add(unsigned* p, unsigned v) { return __hip_atomic_fetch_add(p, v, __ATOMIC_RELAXED, __HIP_MEMORY_SCOPE_AGENT); }
__device__ __forceinline__ unsigned xb_xcc_id() { return (unsigned)__builtin_amdgcn_s_getreg((3 << 11) | 20) & 0xFu; }
#define XB_SPIN(cond, bar) do { unsigned _sp = 0; while (cond) { __builtin_amdgcn_s_sleep(1); \
    if ((++_sp & 255u) == 0u) { if (xb_ld(&(bar)[XB_TMO])) break; if (_sp > XB_SPIN_CAP) { atomicAdd(&(bar)[XB_TMO], 1u); break; } } } } while (0)

struct XcdBarrier {
    unsigned* bar; unsigned x;
    volatile LAS unsigned* st;
};

__device__ __forceinline__ XcdBarrier xcd_barrier_post(unsigned* bar, volatile LAS unsigned* st) {
    XcdBarrier b; b.bar = bar; b.x = xb_xcc_id(); b.st = st;
    if (threadIdx.x == 0) (void)xb_add(&bar[XB_XCNT(b.x)], 1u);
    return b;
}
__device__ __forceinline__ void xcd_barrier_complete(unsigned* bar, unsigned x, unsigned& nloc, unsigned& nx) {
    const unsigned G = gridDim.x * gridDim.y * gridDim.z;
    unsigned sum, cnt, mine, sp = 0u;
    for (;;) {
        sum = 0u; cnt = 0u; mine = 0u;
#pragma unroll
        for (unsigned j = 0; j < 16; ++j) { const unsigned c = xb_ld(&bar[XB_XCNT(j)]); sum += c; cnt += (c > 0u) ? 1u : 0u; mine = (j == x) ? c : mine; }
        if (sum == G) break;
        __builtin_amdgcn_s_sleep(1);
        if ((++sp & 255u) == 0u) { if (xb_ld(&bar[XB_TMO])) break; if (sp > XB_SPIN_CAP) { atomicAdd(&bar[XB_TMO], 1u); break; } }
    }
    nloc = mine > 0u ? mine : 1u; nx = cnt > 0u ? cnt : 1u;
}

__device__ __forceinline__ void xcd_barrier(const XcdBarrier& b) {
    asm volatile("s_waitcnt vmcnt(0)" ::: "memory");
    __syncthreads();
    if (threadIdx.x == 0) {
        unsigned* bar = b.bar;
        __builtin_amdgcn_s_waitcnt(0);
        unsigned nloc = b.st[0], nx = b.st[1];
        if (nloc == 0u) { xcd_barrier_complete(bar, b.x, nloc, nx); b.st[0] = nloc; b.st[1] = nx; }
        const unsigned old = xb_add(&bar[XB_XSUB(b.x)], 1u);
        const unsigned gen = old / nloc;
        if (old + 1u == (gen + 1u) * nloc) {
            __builtin_amdgcn_fence(__ATOMIC_RELEASE, "agent");
            asm volatile("s_waitcnt vmcnt(0)" ::: "memory");
            const unsigned og = xb_add(&bar[XB_TOP], 1u);
            const unsigned tg = og / nx;
            if (og + 1u == (tg + 1u) * nx) xb_add(&bar[XB_TOPGEN], 1u);
            else XB_SPIN(xb_ld(&bar[XB_TOPGEN]) == tg, bar);
            __builtin_amdgcn_fence(__ATOMIC_ACQUIRE, "agent");
            xb_add(&bar[XB_XGEN(b.x)], 1u);
            asm volatile("s_waitcnt vmcnt(0)" ::: "memory");
        } else {
            XB_SPIN(xb_ld(&bar[XB_XGEN(b.x)]) == gen, bar);
            __builtin_amdgcn_fence(__ATOMIC_ACQUIRE, "agent");
            asm volatile("s_waitcnt vmcnt(0)" ::: "memory");
        }
    }
    __syncthreads();
}

namespace pg8 {
constexpr int BM = 256, BK = 64, HALF = 128, HTB = HALF * BK * 2  , STAGE_BYTES = 8 * HTB, NXCD = 8, WGM = 8;
__host__ __device__ __forceinline__ int lds_byte(int r, int c) { const int st = (r >> 4) * 2 + (c >> 5), rr = r & 15, cc = c & 31, ob = rr * 64 + cc * 2; return st * 1024 + (ob ^ (((ob >> 9) & 1) << 5)); }
__host__ __device__ __forceinline__ void stage_rc(int b, int& R, int& C) { const int st = b / 1024, sb = b % 1024, swz = sb ^ (((sb >> 9) & 1) << 5); R = (st >> 1) * 16 + swz / 64; C = (st & 1) * 32 + (swz % 64) / 2; }
__host__ __device__ __forceinline__ int perm32(int rho) { const int n = rho >> 4, i = rho & 15; return 8 * (i >> 2) + 4 * n + (i & 3); }

struct Unit { int pm, pn, x0, x1; };
__device__ __forceinline__ void tile_of(int wgid, int nM, int nN, int& pm, int& pn) {
    const int nwg = nM * nN; { const int q = nwg / NXCD, r = nwg % NXCD, xcd = wgid % NXCD, off = wgid / NXCD; wgid = (xcd < r ? xcd * (q + 1) : r * (q + 1) + (xcd - r) * q) + off; }
    const int nig = WGM * nN, gid = wgid / nig, fm = gid * WGM, gsz = (nM - fm) < WGM ? (nM - fm) : WGM;
    pm = fm + ((wgid % nig) % gsz); pn = (wgid % nig) / gsz;
}

template <class Epi, class Sched, bool ALIGN_EPI>
__device__ __forceinline__ void gemm_phase(LAS unsigned char* lds, const int K, const Sched& S, const Epi& E) {
    const int tid = threadIdx.x, wid = __builtin_amdgcn_readfirstlane(tid >> 6), lane = tid & 63, wr = wid >> 2, wc = wid & 3, fr = lane & 15, fq = lane >> 4;
    const int nt = K / BK;
    unsigned voffA[2], voffB[2];
#pragma unroll
    for (int i = 0; i < 2; ++i) { int R, C; stage_rc(tid * 16 + i * 8192, R, C); const int Rb = Epi::PERM ? ((R & ~31) + perm32(R & 31)) : R;
        voffA[i] = (unsigned)(R * K + C) * 2u; voffB[i] = (unsigned)(Rb * K + C) * 2u; }
    const size_t kstep = (size_t)(BK * 2);
    const size_t hstep = (size_t)HALF * K * 2;
    const unsigned ldsw = (unsigned)wid * 1024u;
    const int aoff = lds_byte(wr * 64 + fr, fq * 8), boff = lds_byte(wc * 32 + fr, fq * 8);
#define PG8_SA(b, h) (((b) * 2 + (h)) * HTB)
#define PG8_SB(b, h) ((4 + (b) * 2 + (h)) * HTB)
#define PG8_STAGE(bufoff, gbase, voff) do { _Pragma("unroll") for (int _i = 0; _i < 2; ++_i) \
        __builtin_amdgcn_global_load_lds((const unsigned*)((const char*)(gbase) + (voff)[_i]), (LAS unsigned*)(lds + (bufoff) + ldsw + _i * 8192), 16, 0, 0); } while (0)
#define PG8_STAGE_A(bufoff, base, h, NX) do { if constexpr (Sched::GATHER) { _Pragma("unroll") for (int _i = 0; _i < 2; ++_i) { const unsigned _o = (NX) ? gN[h][_i] : gA[h][_i]; \
        __builtin_amdgcn_global_load_lds((const unsigned*)((const char*)(base) + _o), (LAS unsigned*)(lds + (bufoff) + ldsw + _i * 8192), 16, 0, 0); } } \
        else { PG8_STAGE(bufoff, (const char*)(base) + (h) * hstep, voffA); } } while (0)
#define PG8_LDA(dst, b, h) do { _Pragma("unroll") for (int m = 0; m < 4; ++m) _Pragma("unroll") for (int k = 0; k < 2; ++k) dst[m][k] = *(const LAS bf16x8*)(lds + PG8_SA(b, h) + aoff + m * 2048 + k * 1024); } while (0)
#define PG8_LDB(dst, b, h) do { _Pragma("unroll") for (int n = 0; n < 2; ++n) _Pragma("unroll") for (int k = 0; k < 2; ++k) dst[n][k] = *(const LAS bf16x8*)(lds + PG8_SB(b, h) + boff + n * 2048 + k * 1024); } while (0)
#define PG8_MMA(ai, bj, At, Bt) do { __builtin_amdgcn_s_setprio(1); _Pragma("unroll") for (int m = 0; m < 4; ++m) _Pragma("unroll") for (int n = 0; n < 2; ++n) _Pragma("unroll") for (int k = 0; k < 2; ++k) \
        acc[ai][bj][m][n] = __builtin_amdgcn_mfma_f32_16x16x32_bf16(Bt[n][k], At[m][k], acc[ai][bj][m][n], 0, 0, 0); __builtin_amdgcn_s_setprio(0); } while (0)
#define PG8_WAIT_V(n) asm volatile("s_waitcnt vmcnt(" #n ")" ::: "memory")
#define PG8_WAIT_L(n) asm volatile("s_waitcnt lgkmcnt(" #n ")" ::: "memory")
#define PG8_BAR __builtin_amdgcn_s_barrier()
#define PG8_SCHED __builtin_amdgcn_sched_barrier(0)
    Unit cur, nxt; int ui = 0;
    if (!S.next(0, cur)) return;
    f32x4 acc[2][2][4][2];
#pragma unroll
    for (int a = 0; a < 2; ++a)
#pragma unroll
        for (int b = 0; b < 2; ++b)
#pragma unroll
            for (int m = 0; m < 4; ++m)
#pragma unroll
                for (int n = 0; n < 2; ++n) acc[a][b][m][n] = (f32x4){0.f, 0.f, 0.f, 0.f};
    bf16x8 At[4][2], B0[2][2], B1[2][2];
    unsigned gA[2][2] = {{0u, 0u}, {0u, 0u}}, gN[2][2] = {{0u, 0u}, {0u, 0u}};
    const char* cA = S.aptr(cur); const char* cB = S.bptr(cur);
    if constexpr (Sched::GATHER) S.aoff(cur, tid, gA);
    PG8_STAGE(PG8_SB(0, 0), cB, voffB); PG8_STAGE(PG8_SB(0, 1), cB + hstep, voffB); PG8_STAGE_A(PG8_SA(0, 0), cA, 0, false); PG8_STAGE_A(PG8_SA(0, 1), cA, 1, false);
    if (wr == 1) PG8_BAR;
    PG8_WAIT_V(2); PG8_BAR;
    PG8_STAGE(PG8_SB(1, 0), cB + kstep, voffB); PG8_STAGE_A(PG8_SA(1, 0), cA + kstep, 0, false); PG8_STAGE(PG8_SB(1, 1), cB + hstep + kstep, voffB);
    PG8_WAIT_V(6); PG8_BAR;
    for (;;) {
        const bool has_next = S.next(ui + 1, nxt);
        const char* nA = has_next ? S.aptr(nxt) : cA; const char* nB = has_next ? S.bptr(nxt) : cB;
        if constexpr (Sched::GATHER) { if (has_next) S.aoff(nxt, tid, gN); else {
#pragma unroll
            for (int h = 0; h < 2; ++h) { gN[h][0] = gA[h][0]; gN[h][1] = gA[h][1]; } } }
        for (int t = 0; t < nt; t += 2) {
            const bool last = (t == nt - 2);
            const char* a1 = cA + (size_t)(t + 1) * kstep;
            const char* a2 = last ? nA : cA + (size_t)(t + 2) * kstep; const char* b2 = last ? nB : cB + (size_t)(t + 2) * kstep;
            const char* a3 = a2 + kstep; const char* b3 = b2 + kstep;
            PG8_LDB(B0, 0, 0); PG8_LDB(B1, 0, 1); PG8_SCHED; PG8_LDA(At, 0, 0); PG8_STAGE_A(PG8_SA(1, 1), a1, 1, false);
            PG8_WAIT_V(8); PG8_WAIT_L(0); PG8_BAR; PG8_MMA(0, 0, At, B0); PG8_MMA(0, 1, At, B1); PG8_BAR; PG8_SCHED;
            PG8_LDA(At, 0, 1); PG8_STAGE(PG8_SB(0, 0), b2, voffB); PG8_STAGE(PG8_SB(0, 1), b2 + hstep, voffB); PG8_STAGE_A(PG8_SA(0, 0), a2, 0, last);
            PG8_WAIT_V(8); PG8_WAIT_L(0); PG8_BAR; PG8_MMA(1, 0, At, B0); PG8_MMA(1, 1, At, B1); PG8_BAR; PG8_SCHED;
            PG8_LDB(B0, 1, 0); PG8_LDB(B1, 1, 1); PG8_SCHED; PG8_LDA(At, 1, 0); PG8_STAGE_A(PG8_SA(0, 1), a2, 1, last);
            PG8_WAIT_V(8); PG8_WAIT_L(0); PG8_BAR; PG8_MMA(0, 0, At, B0); PG8_MMA(0, 1, At, B1); PG8_BAR; PG8_SCHED;
            PG8_LDA(At, 1, 1); PG8_STAGE(PG8_SB(1, 0), b3, voffB); PG8_STAGE(PG8_SB(1, 1), b3 + hstep, voffB); PG8_STAGE_A(PG8_SA(1, 0), a3, 0, last);
            PG8_WAIT_V(8); PG8_WAIT_L(0); PG8_BAR; PG8_MMA(1, 0, At, B0); PG8_MMA(1, 1, At, B1); PG8_BAR; PG8_SCHED;
        }
        if constexpr (ALIGN_EPI) { if (wr == 0) PG8_BAR; }
        E(acc, cur, wr, wc, fr, fq);
        if (!has_next) break;
#pragma unroll
        for (int a = 0; a < 2; ++a)
#pragma unroll
            for (int b = 0; b < 2; ++b)
#pragma unroll
                for (int m = 0; m < 4; ++m)
#pragma unroll
                    for (int n = 0; n < 2; ++n) acc[a][b][m][n] = (f32x4){0.f, 0.f, 0.f, 0.f};
        cur = nxt; cA = nA; cB = nB; ++ui;
        if constexpr (Sched::GATHER) {
#pragma unroll
            for (int h = 0; h < 2; ++h) { gA[h][0] = gN[h][0]; gA[h][1] = gN[h][1]; } }
        if constexpr (ALIGN_EPI) { if (wr == 1) PG8_BAR; }
    }
    PG8_WAIT_V(0);
    if constexpr (!ALIGN_EPI) { if (wr == 0) PG8_BAR; }
    PG8_BAR;
#undef PG8_SA
#undef PG8_SB
#undef PG8_STAGE
#undef PG8_STAGE_A
#undef PG8_LDA
#undef PG8_LDB
#undef PG8_MMA
#undef PG8_WAIT_V
#undef PG8_WAIT_L
#undef PG8_BAR
#undef PG8_SCHED
}
}

struct Frame {
    LAS unsigned char* lds;
    gu32* ctl;
    int tid, lane, wave, G, vcu;
    const float* in[23]; float* out; unsigned char* ws;
};
#define IN_X 0
#define IN_C 1
#define IN_CTX 2
#define IN_CCTX 3
#define IN_WADA 4
#define IN_BADA 5
#define IN_N1W 6
#define IN_WIN 7
#define IN_BMG 8
#define IN_QNW 9
#define IN_KNW 10
#define IN_MHW 11
#define IN_WBM 12
#define IN_WBA 13
#define IN_WOUT 14
#define IN_N2W 15
#define IN_WRG 16
#define IN_BRG 17
#define IN_WRE 18
#define IN_BRE 19
#define IN_WEG 20
#define IN_WEU 21
#define IN_WED 22

__device__ __forceinline__ void p0_ada(Frame& F) {
    LAS float* sl = (LAS float*)F.lds;
    LAS float* red = sl + 17 * 1024;
    const float* cc = F.in[IN_C]; const float* cx = F.in[IN_CCTX];
    for (int i = F.tid; i < 17 * 1024; i += NTHREADS) { const int r = i >> 10, k = i & 1023; const float c = r < 16 ? cc[r * 1024 + k] : cx[k]; sl[i] = siluf_(c); }
    __syncthreads();
    const float* W = F.in[IN_WADA]; const float* bias = F.in[IN_BADA]; float* mod = (float*)(F.ws + WS_MOD);
    const int j = F.lane & 31, kk = F.lane >> 5;
    for (int cb = blockIdx.x; cb < 256; cb += F.G) {
        const int col0 = cb * 24;
        float acc[17];
#pragma unroll
        for (int r = 0; r < 17; ++r) acc[r] = 0.f;
        if (j < 24) {
#pragma unroll 4
            for (int it = 0; it < 64; ++it) { const int k = F.wave * 128 + it * 2 + kk; const float w = W[(size_t)k * NMOD + col0 + j];
#pragma unroll
                for (int r = 0; r < 17; ++r) acc[r] += sl[r * 1024 + k] * w; }
        }
#pragma unroll
        for (int r = 0; r < 17; ++r) acc[r] += __shfl_xor(acc[r], 32);
        if (F.lane < 32) {
#pragma unroll
            for (int r = 0; r < 17; ++r) red[(F.wave * 17 + r) * 32 + j] = acc[r]; }
        __syncthreads();
        if (F.tid < 17 * 24) { const int r = F.tid / 24, jj = F.tid % 24; float s = 0.f;
#pragma unroll
            for (int w = 0; w < 8; ++w) s += red[(w * 17 + r) * 32 + jj];
            mod[r * NMOD + col0 + jj] = s + bias[col0 + jj]; }
        __syncthreads();
    }
}
template <class DR>
__device__ __forceinline__ void transpose_item(const float* W, int K, int N, bf16_t* WT, const DR& destrow, LAS float* scr, int item, int lane) {
    const int nblk = N / 32, kb = item / nblk, nb = item % nblk, k0 = 64 * kb, n0 = 32 * nb;
#pragma unroll 8
    for (int i = 0; i < 32; ++i) { const int kk = 2 * i + (lane >> 5); scr[kk * 33 + (lane & 31)] = W[(size_t)(k0 + kk) * N + n0 + (lane & 31)]; }
    LDS_WAIT(); asm volatile("" ::: "memory");
    const int c = lane & 7;
#pragma unroll
    for (int j = 0; j < 4; ++j) { const int n = (lane >> 3) + 8 * j; const LAS float* s = scr + (8 * c) * 33 + n;
        u32x4 o; o.x = pk2(s[0 * 33], s[1 * 33]); o.y = pk2(s[2 * 33], s[3 * 33]); o.z = pk2(s[4 * 33], s[5 * 33]); o.w = pk2(s[6 * 33], s[7 * 33]);
        *(GAS u32x4*)(WT + (size_t)destrow(n0 + n) * K + k0 + 8 * c) = o; }
    LDS_WAIT(); asm volatile("" ::: "memory");
}
struct DrIdent { int off; __device__ __forceinline__ int operator()(int n) const { return off + n; } };
struct DrWin { __device__ __forceinline__ int operator()(int n) const {
    if (n < 1024) return 2816 + n;
    if (n < 2048) return n - 1024;
    if (n < 3072) return 1024 + (n - 2048);
    if (n < 4096) return 3840 + (n - 3072);
    if (n < 4128) return 2560 + (n - 4096);
    if (n < 5152) return 4864 + (n - 4128);
    if (n < 5408) return 2048 + (n - 5152);
    if (n < 5664) return 2304 + (n - 5408);
    return 5888 + (n - 5664); } };
__device__ __forceinline__ void p0_prologue(Frame& F) {
    p0_ada(F);
    __syncthreads();
    LAS float* scr = (LAS float*)(F.lds + F.wave * 16384);
    const int gw = F.vcu * NWAVES + F.wave, NGW = F.G * NWAVES;
    constexpr int I_IN = 16 * (IN_W / 32), I_SQ = 16 * 32;
    bf16_t* win_t = (bf16_t*)(F.ws + WS_WIN);
    for (int it = gw; it < I_IN + 3 * I_SQ; it += NGW) {
        int r = it;
        if (r < I_IN) { transpose_item(F.in[IN_WIN], D, IN_W, win_t, DrWin{}, scr, r, F.lane); continue; } r -= I_IN;
        if (r < I_SQ) { transpose_item(F.in[IN_WBM], D, D, (bf16_t*)(F.ws + WS_WBM), DrIdent{0}, scr, r, F.lane); continue; } r -= I_SQ;
        if (r < I_SQ) { transpose_item(F.in[IN_WBA], D, D, (bf16_t*)(F.ws + WS_WBA), DrIdent{0}, scr, r, F.lane); continue; } r -= I_SQ;
        transpose_item(F.in[IN_WOUT], D, D, (bf16_t*)(F.ws + WS_WO), DrIdent{0}, scr, r, F.lane);
    }
    { GAS u32x4* z = (GAS u32x4*)(win_t + (size_t)2592 * D); const int n16 = 224 * D * 2 / 16;
      for (int i = blockIdx.x * NTHREADS + F.tid; i < n16; i += F.G * NTHREADS) z[i] = (u32x4){0u, 0u, 0u, 0u}; }
    { float* tab = (float*)(F.ws + WS_ROPE);
      for (int i = blockIdx.x * NTHREADS + F.tid; i < 2048; i += F.G * NTHREADS) { const int pos = i >> 5, fi = i & 31;
          const float inv = powf(10000.0f, -(float)(2 * fi) / 64.0f); const float ang = (float)pos * inv; tab[i] = cosf(ang); tab[2048 + i] = sinf(ang); } }
}

__device__ __forceinline__ void p1_a0(Frame& F) {
    const int gw = F.vcu * NWAVES + F.wave, NGW = F.G * NWAVES;
    const float* mod = (const float*)(F.ws + WS_MOD); const float* n1w = F.in[IN_N1W]; bf16_t* A0 = (bf16_t*)(F.ws + WS_A0);
    for (int row = gw; row < T_ALL; row += NGW) {
        const float* src = row < T_LAT ? F.in[IN_X] + (size_t)row * D : F.in[IN_CTX] + (size_t)(row - T_LAT) * D;
        const int mr = row < T_LAT ? row / SEQ : 16;
        const GAS f32x4* xr = (const GAS f32x4*)src + F.lane;
        f32x4 v[4]; float s = 0.f;
#pragma unroll
        for (int j = 0; j < 4; ++j) { v[j] = xr[64 * j]; s += (v[j].x * v[j].x + v[j].y * v[j].y) + (v[j].z * v[j].z + v[j].w * v[j].w); }
        const float rinv = 1.0f / sqrtf(wave_sum(s) * (1.0f / D) + EPS);
        GAS u32x2* o8 = (GAS u32x2*)(A0 + (size_t)row * D) + F.lane;
#pragma unroll
        for (int j = 0; j < 4; ++j) { const int col = 256 * j + 4 * F.lane;
            const f32x4 w = *(const f32x4*)(n1w + col), sh = *(const f32x4*)(mod + mr * NMOD + col), sc = *(const f32x4*)(mod + mr * NMOD + D + col);
            const f32x4 y = (v[j] * rinv) * w * (sc + 1.0f) + sh;
            u32x2 o; o.x = pk2(y.x, y.y); o.y = pk2(y.z, y.w); o8[64 * j] = o; }
    }
}

struct InProjOrder { static constexpr bool GATHER = false; const char* A; const char* Bt; int G, c;
    __device__ __forceinline__ bool next(int i, pg8::Unit& u) const { const long L = (long)i * G + c; constexpr int NL = MT_LAT * NT_LAT, NC = MT_CTX * NT_CTX; if (L >= NL + NC) return false;
        if (L < NL) pg8::tile_of((int)L, MT_LAT, NT_LAT, u.pm, u.pn); else { const int q = (int)L - NL; u.pm = MT_LAT + q % MT_CTX; u.pn = q / MT_CTX; } u.x0 = 0; u.x1 = 0; return true; }
    __device__ __forceinline__ const char* aptr(const pg8::Unit& u) const { return A + (size_t)u.pm * (256 * D * 2); }
    __device__ __forceinline__ const char* bptr(const pg8::Unit& u) const { return Bt + (size_t)u.pn * (256 * D * 2); }
    __device__ __forceinline__ void aoff(const pg8::Unit&, int, unsigned (&)[2][2]) const {}
};
__device__ __forceinline__ int krow_of(int r0) { if (r0 < T_LAT) return (r0 / SEQ) * KVL + (r0 % SEQ); const int q = r0 - T_LAT; return (q / CTXL) * KVL + SEQ + (q % CTXL); }
struct EpiInProj { static constexpr bool PERM = true; unsigned char* ws; bf16_t* mg; const float* bgate;
    __device__ __forceinline__ void operator()(const f32x4 (&acc)[2][2][4][2], const pg8::Unit& u, int wr, int wc, int fr, int fq) const {
        const int pn = u.pn; int r0 = u.pm * 256; bf16_t* base; int ldc = D, colt;
        if (pn == 10) {
            if (wc == 0) { float* g = (float*)(ws + WS_GATES); const f32x4 b0 = *(const f32x4*)(bgate + 8 * fq), b1 = *(const f32x4*)(bgate + 8 * fq + 4);
#pragma unroll
                for (int ai = 0; ai < 2; ++ai)
#pragma unroll
                    for (int m = 0; m < 4; ++m) { float* p = g + (size_t)(r0 + ai * 128 + wr * 64 + m * 16 + fr) * 32 + 8 * fq;
                        *(f32x4*)p = acc[ai][0][m][0] + b0; *(f32x4*)(p + 4) = acc[ai][0][m][1] + b1; } }
            return; }
        if (pn < 4) { base = (bf16_t*)(ws + WS_MK); colt = pn * 256; }
        else if (pn < 8) { base = (bf16_t*)(ws + WS_MV); colt = (pn - 4) * 256; }
        else if (pn < 10) { base = (bf16_t*)(ws + (pn == 8 ? WS_AK : WS_AV)); ldc = 256; colt = 0; r0 = krow_of(r0); }
        else if (pn < 15) { base = (bf16_t*)(ws + WS_MQ); colt = (pn - 11) * 256; }
        else if (pn < 19) { base = (bf16_t*)(ws + WS_OG); colt = (pn - 15) * 256; }
        else if (pn < 23) { base = (bf16_t*)(ws + WS_AQ); colt = (pn - 19) * 256; }
        else { base = mg; ldc = 2 * D; colt = (pn - 23) * 256; }
        const int row0 = r0 + wr * 64 + fr, col0 = colt + wc * 32 + 8 * fq;
#pragma unroll
        for (int ai = 0; ai < 2; ++ai)
#pragma unroll
            for (int m = 0; m < 4; ++m) { bf16_t* rowp = base + (size_t)(row0 + ai * 128 + m * 16) * ldc + col0;
#pragma unroll
                for (int bj = 0; bj < 2; ++bj) { const f32x4 v0 = acc[ai][bj][m][0], v1 = acc[ai][bj][m][1];
                    u32x4 w; w.x = cvt_pk_bf16(v0[0], v0[1]); w.y = cvt_pk_bf16(v0[2], v0[3]); w.z = cvt_pk_bf16(v1[0], v1[1]); w.w = cvt_pk_bf16(v1[2], v1[3]);
                    *(u32x4*)(rowp + bj * 128) = w; } }
    }
};

__device__ __forceinline__ void p3_qknorm(Frame& F) {
    const int gw = F.vcu * NWAVES + F.wave, NGW = F.G * NWAVES;
    const float* tab = (const float*)(F.ws + WS_ROPE);
    constexpr int NQ = T_LAT, NK = NB * KVL / 4;
    const int l8 = F.lane & 7;
    for (int it = gw; it < NQ + NK; it += NGW) {
        bf16_t* p; const float* nw; int t;
        if (it < NQ) { p = (bf16_t*)(F.ws + WS_AQ) + (size_t)it * D + 16 * F.lane; nw = F.in[IN_QNW]; t = it % SEQ; }
        else { const int kr = (it - NQ) * 4 + (F.lane >> 4); p = (bf16_t*)(F.ws + WS_AK) + (size_t)kr * 256 + 16 * (F.lane & 15); nw = F.in[IN_KNW]; const int pos = kr % KVL; t = pos < SEQ ? pos : -1; }
        const u32x4 w0 = *(const GAS u32x4*)p, w1 = *(const GAS u32x4*)(p + 8);
        float x[16];
        x[0] = bflo(w0.x); x[1] = bfhi(w0.x); x[2] = bflo(w0.y); x[3] = bfhi(w0.y); x[4] = bflo(w0.z); x[5] = bfhi(w0.z); x[6] = bflo(w0.w); x[7] = bfhi(w0.w);
        x[8] = bflo(w1.x); x[9] = bfhi(w1.x); x[10] = bflo(w1.y); x[11] = bfhi(w1.y); x[12] = bflo(w1.z); x[13] = bfhi(w1.z); x[14] = bflo(w1.w); x[15] = bfhi(w1.w);
        float ss = 0.f;
#pragma unroll
        for (int j = 0; j < 16; ++j) ss += x[j] * x[j];
        ss += __shfl_xor(ss, 1); ss += __shfl_xor(ss, 2); ss += __shfl_xor(ss, 4);
        const float rinv = 1.0f / sqrtf(ss * (1.0f / 128.0f) + EPS);
#pragma unroll
        for (int j = 0; j < 16; ++j) x[j] = (x[j] * rinv) * nw[16 * l8 + j];
        const bool isx2 = (l8 & 2) != 0; const int partner = isx2 ? F.lane - 2 : F.lane + 2;
        float y[16];
#pragma unroll
        for (int j = 0; j < 16; ++j) y[j] = __shfl(x[j], partner);
        if (t >= 0) { const int pos = (l8 & 4) ? (t & 63) : (t >> 6); const float* cs = tab + pos * 32 + 16 * (l8 & 1); const float* sn = cs + 2048;
#pragma unroll
            for (int j = 0; j < 16; ++j) { const float c = cs[j], s = sn[j]; x[j] = isx2 ? (x[j] * c + y[j] * s) : (x[j] * c - y[j] * s); } }
        u32x4 o0, o1;
        o0.x = pk2(x[0], x[1]); o0.y = pk2(x[2], x[3]); o0.z = pk2(x[4], x[5]); o0.w = pk2(x[6], x[7]);
        o1.x = pk2(x[8], x[9]); o1.y = pk2(x[10], x[11]); o1.z = pk2(x[12], x[13]); o1.w = pk2(x[14], x[15]);
        *(GAS u32x4*)p = o0; *(GAS u32x4*)(p + 8) = o1;
    }
}

namespace ml {
constexpr int PQ = 272, PT = 144, PH = 528;
constexpr int QS = 0, KS = 64 * PQ, HST = 0;
constexpr int KT = 2 * 64 * PQ;
constexpr int VT = KT + 128 * PT;
constexpr int CT = VT + 128 * PT;
constexpr int PP = CT + 128 * PQ;
constexpr int SC = PP + 64 * PT;
constexpr int S_A = 0, S_M = 64, S_WI = 128, S_EQ = 192, S_WIN = 256, S_RS0 = 320, S_RS1 = 384, S_QN = 448, S_N = 512, S_WOLD = 640;
constexpr int END = SC + 4096;
static_assert(64 * PH <= 2 * 64 * PQ, "h staging fits over q|k");
constexpr float QSCALE = 0.08838834764831845f;

__device__ __forceinline__ bf16x8 frag(const LAS unsigned char* base, int pitch, int tile, int ks, int lane) {
    return *(const LAS bf16x8*)(base + (16 * tile + (lane & 15)) * pitch + (32 * ks + 8 * (lane >> 4)) * 2);
}
__device__ __forceinline__ float logsig(float x) { return fminf(x, 0.f) - log1pf(expf(-fabsf(x))); }

__device__ __forceinline__ void unit(Frame& F, int b, int h) {
    LAS unsigned char* L = F.lds; LAS float* sc = (LAS float*)(L + SC);
    const int tid = F.tid, lane = F.lane, w = F.wave;
    const bf16_t* MQ = (const bf16_t*)(F.ws + WS_MQ); const bf16_t* MK = (const bf16_t*)(F.ws + WS_MK); const bf16_t* MV = (const bf16_t*)(F.ws + WS_MV);
    const bf16_t* OG = (const bf16_t*)(F.ws + WS_OG); bf16_t* HT = (bf16_t*)(F.ws + WS_HTMP); bf16_t* AM = (bf16_t*)(F.ws + WS_MQ);
    const float* GT = (const float*)(F.ws + WS_GATES); const float* mhw = F.in[IN_MHW];
    const int lr = tid >> 3, seg = tid & 7;
    for (int dir = 0; dir < 2; ++dir) {
        f32x4 accC[8];
#pragma unroll
        for (int e = 0; e < 8; ++e) accC[e] = (f32x4){0.f, 0.f, 0.f, 0.f};
        for (int i = tid; i < 128 * PQ / 4; i += NTHREADS) ((LAS unsigned*)(L + CT))[i] = 0u;
        if (tid < 128) sc[S_N + tid] = 0.f;
        float m_run = -1e30f;
        u32x4 rq0, rq1, rk0, rk1, rv0, rv1; float g_i = 0.f, g_f = 0.f;
        rq0 = rq1 = rk0 = rk1 = rv0 = rv1 = (u32x4){0u, 0u, 0u, 0u};
#define ML_GROW(st, r) ((st) < 4 ? (T_LAT + b * CTXL + (dir == 0 ? (st) * 64 + (r) : (3 - (st)) * 64 + 63 - (r))) : (b * SEQ + (dir == 0 ? ((st) - 4) * 64 + (r) : (35 - (st)) * 64 + 63 - (r))))
#define ML_LOAD(st) do { const size_t go = (size_t)ML_GROW(st, lr) * D + h * 128 + seg * 16; \
            if ((st) >= 4) { rq0 = *(const GAS u32x4*)(MQ + go); rq1 = *(const GAS u32x4*)(MQ + go + 8); } \
            rk0 = *(const GAS u32x4*)(MK + go); rk1 = *(const GAS u32x4*)(MK + go + 8); rv0 = *(const GAS u32x4*)(MV + go); rv1 = *(const GAS u32x4*)(MV + go + 8); \
            if (w == 0) { const float* gp = GT + (size_t)ML_GROW(st, lane) * 32 + dir * 16 + h; g_i = gp[0]; g_f = gp[8]; } } while (0)
        ML_LOAD(0);
        for (int st = 0; st < 36; ++st) {
            const bool lat = st >= 4;
            if (w == 0) {
                const float lf = logsig(g_f);
                float bc = lf;
#pragma unroll
                for (int o = 1; o < 64; o <<= 1) { const float t = __shfl_up(bc, o); if (lane >= o) bc += t; }
                const float a = g_i - bc;
                float pm = a;
#pragma unroll
                for (int o = 1; o < 64; o <<= 1) { const float t = __shfl_up(pm, o); if (lane >= o) pm = fmaxf(pm, t); }
                const float M = fmaxf(m_run, pm);
                const float blast = __shfl(bc, 63);
                const float dec = blast - bc + g_i;
                const float mnew = fmaxf(blast + m_run, wave_max(dec));
                sc[S_A + lane] = a; sc[S_M + lane] = M; sc[S_WI + lane] = expf(m_run - M); sc[S_EQ + lane] = expf(-(bc + M)); sc[S_WIN + lane] = expf(dec - mnew);
                if (lane == 0) sc[S_WOLD] = expf(blast + m_run - mnew);
                m_run = mnew;
            }
            LDS_WAIT(); __syncthreads();
            {
                const float win = sc[S_WIN + lr];
                if (lat) { *(LAS u32x4*)(L + QS + lr * PQ + seg * 32) = rq0; *(LAS u32x4*)(L + QS + lr * PQ + seg * 32 + 16) = rq1;
                           *(LAS u32x4*)(L + KS + lr * PQ + seg * 32) = rk0; *(LAS u32x4*)(L + KS + lr * PQ + seg * 32 + 16) = rk1; }
                const unsigned kw[8] = {rk0.x, rk0.y, rk0.z, rk0.w, rk1.x, rk1.y, rk1.z, rk1.w};
                const unsigned vw[8] = {rv0.x, rv0.y, rv0.z, rv0.w, rv1.x, rv1.y, rv1.z, rv1.w};
#pragma unroll
                for (int j = 0; j < 8; ++j) {
                    LAS unsigned short* kt = (LAS unsigned short*)(L + KT + (seg * 16 + 2 * j) * PT + lr * 2);
                    kt[0] = (unsigned short)f2bf(bflo(kw[j]) * win); kt[PT / 2] = (unsigned short)f2bf(bfhi(kw[j]) * win);
                    LAS unsigned short* vt = (LAS unsigned short*)(L + VT + (seg * 16 + 2 * j) * PT + lr * 2);
                    vt[0] = (unsigned short)(vw[j] & 0xffffu); vt[PT / 2] = (unsigned short)(vw[j] >> 16);
                }
            }
            if (st + 1 < 36) ML_LOAD(st + 1);
            LDS_WAIT(); __syncthreads();
            f32x4 acch[4];
            const int si = w >> 1, eb = 4 * (w & 1);
            if (lat) {
                bf16x8 qf[4];
#pragma unroll
                for (int ks = 0; ks < 4; ++ks) qf[ks] = frag(L + QS, PQ, si, ks, lane);
                const int s_col = 16 * si + (lane & 15); const float Ms = sc[S_M + s_col];
                float psum = 0.f;
#pragma unroll
                for (int rr = 0; rr < 2; ++rr) { const int ri = 2 * (w & 1) + rr; f32x4 a4 = (f32x4){0.f, 0.f, 0.f, 0.f};
#pragma unroll
                    for (int ks = 0; ks < 4; ++ks) a4 = __builtin_amdgcn_mfma_f32_16x16x32_bf16(frag(L + KS, PQ, ri, ks, lane), qf[ks], a4, 0, 0, 0);
                    const int r0 = 16 * ri + 4 * (lane >> 4); float p[4];
#pragma unroll
                    for (int j = 0; j < 4; ++j) { const int r = r0 + j; p[j] = (r <= s_col) ? a4[j] * QSCALE * __expf(sc[S_A + r] - Ms) : 0.f; psum += p[j]; }
                    u32x2 pw; pw.x = pk2(p[0], p[1]); pw.y = pk2(p[2], p[3]);
                    *(LAS u32x2*)(L + PP + s_col * PT + r0 * 2) = pw; }
                psum += __shfl_xor(psum, 16); psum += __shfl_xor(psum, 32);
                if (lane < 16) sc[((w & 1) ? S_RS1 : S_RS0) + s_col] = psum;
                { const u32x4 q0 = *(const LAS u32x4*)(L + QS + lr * PQ + seg * 32), q1 = *(const LAS u32x4*)(L + QS + lr * PQ + seg * 32 + 16);
                  const LAS float* nv = sc + S_N + seg * 16;
                  float d = bflo(q0.x) * nv[0] + bfhi(q0.x) * nv[1] + bflo(q0.y) * nv[2] + bfhi(q0.y) * nv[3] + bflo(q0.z) * nv[4] + bfhi(q0.z) * nv[5] + bflo(q0.w) * nv[6] + bfhi(q0.w) * nv[7]
                          + bflo(q1.x) * nv[8] + bfhi(q1.x) * nv[9] + bflo(q1.y) * nv[10] + bfhi(q1.y) * nv[11] + bflo(q1.z) * nv[12] + bfhi(q1.z) * nv[13] + bflo(q1.w) * nv[14] + bfhi(q1.w) * nv[15];
                  d += __shfl_xor(d, 1); d += __shfl_xor(d, 2); d += __shfl_xor(d, 4);
                  if (seg == 0) sc[S_QN + lr] = d; }
#pragma unroll
                for (int e = 0; e < 4; ++e) { acch[e] = (f32x4){0.f, 0.f, 0.f, 0.f};
#pragma unroll
                    for (int ks = 0; ks < 4; ++ks) acch[e] = __builtin_amdgcn_mfma_f32_16x16x32_bf16(qf[ks], frag(L + CT, PQ, eb + e, ks, lane), acch[e], 0, 0, 0); }
            }
            LDS_WAIT(); __syncthreads();
            {
                const float wold = sc[S_WOLD];
                const bf16x8 ka0 = frag(L + KT, PT, w, 0, lane), ka1 = frag(L + KT, PT, w, 1, lane);
#pragma unroll
                for (int e = 0; e < 8; ++e) { accC[e] = accC[e] * wold;
                    accC[e] = __builtin_amdgcn_mfma_f32_16x16x32_bf16(ka0, frag(L + VT, PT, e, 0, lane), accC[e], 0, 0, 0);
                    accC[e] = __builtin_amdgcn_mfma_f32_16x16x32_bf16(ka1, frag(L + VT, PT, e, 1, lane), accC[e], 0, 0, 0);
                    u32x2 cw; cw.x = pk2(accC[e][0], accC[e][1]); cw.y = pk2(accC[e][2], accC[e][3]);
                    *(LAS u32x2*)(L + CT + (16 * e + (lane & 15)) * PQ + (16 * w + 4 * (lane >> 4)) * 2) = cw; }
                { const int d = tid >> 2, rq = tid & 3; const u32x4 k0 = *(const LAS u32x4*)(L + KT + d * PT + rq * 32), k1 = *(const LAS u32x4*)(L + KT + d * PT + rq * 32 + 16);
                  float s = bflo(k0.x) + bfhi(k0.x) + bflo(k0.y) + bfhi(k0.y) + bflo(k0.z) + bfhi(k0.z) + bflo(k0.w) + bfhi(k0.w)
                          + bflo(k1.x) + bfhi(k1.x) + bflo(k1.y) + bfhi(k1.y) + bflo(k1.z) + bfhi(k1.z) + bflo(k1.w) + bfhi(k1.w);
                  s += __shfl_xor(s, 1); s += __shfl_xor(s, 2);
                  if (rq == 0) sc[S_N + d] = wold * sc[S_N + d] + s; }
            }
            if (lat) {
                const int s0 = 16 * si + 4 * (lane >> 4);
                float rwi[4], rden[4];
#pragma unroll
                for (int j = 0; j < 4; ++j) { const int s = s0 + j; rwi[j] = QSCALE * sc[S_WI + s]; const float den = rwi[j] * sc[S_QN + s] + sc[S_RS0 + s] + sc[S_RS1 + s]; rden[j] = 1.0f / fmaxf(fabsf(den), sc[S_EQ + s]); }
                const bf16x8 pf0 = frag(L + PP, PT, si, 0, lane), pf1 = frag(L + PP, PT, si, 1, lane);
#pragma unroll
                for (int e = 0; e < 4; ++e) {
#pragma unroll
                    for (int j = 0; j < 4; ++j) acch[e][j] *= rwi[j];
                    acch[e] = __builtin_amdgcn_mfma_f32_16x16x32_bf16(pf0, frag(L + VT, PT, eb + e, 0, lane), acch[e], 0, 0, 0);
                    acch[e] = __builtin_amdgcn_mfma_f32_16x16x32_bf16(pf1, frag(L + VT, PT, eb + e, 1, lane), acch[e], 0, 0, 0);
#pragma unroll
                    for (int j = 0; j < 4; ++j) *(LAS float*)(L + HST + (s0 + j) * PH + (16 * (eb + e) + (lane & 15)) * 4) = acch[e][j] * rden[j]; }
            }
            LDS_WAIT(); __syncthreads();
            if (lat) {
                const LAS f32x4* hp = (const LAS f32x4*)(L + HST + lr * PH + seg * 64);
                f32x4 hv[4];
#pragma unroll
                for (int j = 0; j < 4; ++j) hv[j] = hp[j];
                const size_t go = (size_t)ML_GROW(st, lr) * D + h * 128 + seg * 16;
                if (dir == 0) {
                    u32x4 o0, o1; o0.x = pk2(hv[0].x, hv[0].y); o0.y = pk2(hv[0].z, hv[0].w); o0.z = pk2(hv[1].x, hv[1].y); o0.w = pk2(hv[1].z, hv[1].w);
                    o1.x = pk2(hv[2].x, hv[2].y); o1.y = pk2(hv[2].z, hv[2].w); o1.z = pk2(hv[3].x, hv[3].y); o1.w = pk2(hv[3].z, hv[3].w);
                    *(GAS u32x4*)(HT + go) = o0; *(GAS u32x4*)(HT + go + 8) = o1;
                } else {
                    const u32x4 f0 = *(const GAS u32x4*)(HT + go), f1 = *(const GAS u32x4*)(HT + go + 8), g0 = *(const GAS u32x4*)(OG + go), g1 = *(const GAS u32x4*)(OG + go + 8);
                    const unsigned fw[8] = {f0.x, f0.y, f0.z, f0.w, f1.x, f1.y, f1.z, f1.w}, gw[8] = {g0.x, g0.y, g0.z, g0.w, g1.x, g1.y, g1.z, g1.w};
                    float x[16]; float ss = 0.f;
#pragma unroll
                    for (int j = 0; j < 8; ++j) { x[2 * j] = hv[j >> 1][(2 * j) & 3] + bflo(fw[j]); x[2 * j + 1] = hv[j >> 1][(2 * j + 1) & 3] + bfhi(fw[j]); ss += x[2 * j] * x[2 * j] + x[2 * j + 1] * x[2 * j + 1]; }
                    ss += __shfl_xor(ss, 1); ss += __shfl_xor(ss, 2); ss += __shfl_xor(ss, 4);
                    const float rinv = 1.0f / sqrtf(ss * (1.0f / 128.0f) + EPS);
                    const float* mw = mhw + h * 128 + seg * 16; unsigned ow[8];
#pragma unroll
                    for (int j = 0; j < 8; ++j) { const float y0 = (x[2 * j] * rinv) * mw[2 * j] * sigmoidf_(bflo(gw[j])), y1 = (x[2 * j + 1] * rinv) * mw[2 * j + 1] * sigmoidf_(bfhi(gw[j])); ow[j] = pk2(y0, y1); }
                    *(GAS u32x4*)(AM + go) = (u32x4){ow[0], ow[1], ow[2], ow[3]}; *(GAS u32x4*)(AM + go + 8) = (u32x4){ow[4], ow[5], ow[6], ow[7]};
                }
            }
        }
        VM_WAIT(); __syncthreads();
#undef ML_LOAD
#undef ML_GROW
    }
}
}

namespace at {
constexpr int QBLK = 32, KVBLK = 64, LDQ = D, LDK = 256, LDO = D;
constexpr float SCALE = 0.088388347648318440f;
constexpr float THR = 8.f;
constexpr size_t SHM_V = KVBLK * 128 * 2, SHM_K = KVBLK * 128 * 2, SHM_ATTN = 2 * SHM_V + 2 * SHM_K + NWAVES * 64 * 4;
#define KSWZ(row, colB) ((row) * 256 + ((colB) ^ (((row) & 7) << 4)))
#define SBAR() __builtin_amdgcn_sched_barrier(0)
__device__ __forceinline__ int crow(int r, int hi) { return (r & 3) + 8 * (r >> 2) + 4 * hi; }
__device__ __forceinline__ void partialSM(f32x16& p0, f32x16& p1, float& m_reg, float& mn, float& alpha) {
  constexpr float C = SCALE * 1.4426950408889634f;
  float pmax = p0[0];
#pragma unroll
  for (int r = 1; r < 16; ++r) pmax = fmaxf(pmax, p0[r]);
#pragma unroll
  for (int r = 0; r < 16; ++r) pmax = fmaxf(pmax, p1[r]);
  { auto rr = __builtin_amdgcn_permlane32_swap(__float_as_uint(pmax), __float_as_uint(pmax), false, false);
    pmax = fmaxf(__uint_as_float(rr[0]), __uint_as_float(rr[1])); }
  if (__builtin_expect(__all(pmax - m_reg <= THR / SCALE), 1)) { mn = m_reg; alpha = 1.f; }
  else { mn = fmaxf(m_reg, pmax); alpha = __builtin_amdgcn_exp2f((m_reg - mn) * C); m_reg = mn; }
  float mnC = -mn * C;
#pragma unroll
  for (int r = 0; r < 16; ++r) p0[r] = fmaf(p0[r], C, mnC);
#pragma unroll
  for (int r = 0; r < 16; ++r) p1[r] = fmaf(p1[r], C, mnC);
#pragma unroll
  for (int r = 0; r < 16; ++r) p0[r] = __builtin_amdgcn_exp2f(p0[r]);
}
__device__ __forceinline__ void finishSM(f32x16& p0, f32x16& p1, float alpha, float& l_reg, bf16x8& pa0, bf16x8& pa1, bf16x8& pa2, bf16x8& pa3) {
#pragma unroll
  for (int r = 0; r < 16; ++r) p1[r] = __builtin_amdgcn_exp2f(p1[r]);
  float ps = 0;
#pragma unroll
  for (int r = 0; r < 16; ++r) ps += p0[r];
#pragma unroll
  for (int r = 0; r < 16; ++r) ps += p1[r];
  { auto rr = __builtin_amdgcn_permlane32_swap(__float_as_uint(ps), __float_as_uint(ps), false, false);
    ps = __uint_as_float(rr[0]) + __uint_as_float(rr[1]); }
  l_reg = l_reg * alpha + ps;
#define PK4(P, BASE, OUT) do { unsigned a0 = cvt_pk_bf16(P[BASE + 0], P[BASE + 1]), a1 = cvt_pk_bf16(P[BASE + 2], P[BASE + 3]);   \
    unsigned b0 = cvt_pk_bf16(P[BASE + 4], P[BASE + 5]), b1 = cvt_pk_bf16(P[BASE + 6], P[BASE + 7]);                              \
    auto r0 = __builtin_amdgcn_permlane32_swap(a0, b0, false, false); auto r1 = __builtin_amdgcn_permlane32_swap(a1, b1, false, false); \
    u32x4 w = {r0[0], r1[0], r0[1], r1[1]}; OUT = *reinterpret_cast<bf16x8*>(&w); } while (0)
  PK4(p0, 0, pa0); PK4(p0, 8, pa1); PK4(p1, 0, pa2); PK4(p1, 8, pa3);
#undef PK4
}
__device__ __forceinline__ void qkt(f32x16& p0, f32x16& p1, const char* Ks, const bf16x8* qr, int r32, int hi) {
  p0 = f32x16{}; p1 = f32x16{};
#pragma unroll
  for (int d0 = 0; d0 < 8; ++d0) { int cb = (d0 * 16 + hi * 8) * 2;
    bf16x8 b0 = *reinterpret_cast<const bf16x8*>(Ks + KSWZ(r32, cb));
    bf16x8 b1 = *reinterpret_cast<const bf16x8*>(Ks + KSWZ(32 + r32, cb));
    p0 = __builtin_amdgcn_mfma_f32_32x32x16_bf16(b0, qr[d0], p0, 0, 0, 0);
    p1 = __builtin_amdgcn_mfma_f32_32x32x16_bf16(b1, qr[d0], p1, 0, 0, 0); }
}
__device__ __forceinline__ int v_st(int k, int c) { const int kk = (k & ~0xC) | ((k & 4) << 1) | ((k & 8) >> 1); return ((kk >> 3) * 4 + (c >> 5)) * 512 + ((kk & 7) * 32 + (c & 31)) * 2; }
__device__ __forceinline__ int v_rd_base(int lane) { return ((lane & 3) << 3) | (((lane >> 2) & 3) << 6) | (((lane >> 4) & 1) << 5) | (((lane >> 5) & 1) << 8); }
constexpr int v_rd_off(int d0, int ks, int half) { return d0 * 512 + ks * 4096 + half * 2048; }
template <int OFF> __device__ __forceinline__ s16x4 tr_read(int vb) {
  s16x4 r; asm volatile("ds_read_b64_tr_b16 %0, %1 offset:%2" : "=&v"(r) : "v"(vb), "i"(OFF) : "memory"); return r;
}
template <int D0> __device__ __forceinline__ void pv_one(f32x16& od, int vb, bf16x8 pa0, bf16x8 pa1, bf16x8 pa2, bf16x8 pa3) {
  const s16x4 l0 = tr_read<v_rd_off(D0, 0, 0)>(vb), h0 = tr_read<v_rd_off(D0, 0, 1)>(vb), l1 = tr_read<v_rd_off(D0, 1, 0)>(vb), h1 = tr_read<v_rd_off(D0, 1, 1)>(vb);
  const s16x4 l2 = tr_read<v_rd_off(D0, 2, 0)>(vb), h2 = tr_read<v_rd_off(D0, 2, 1)>(vb), l3 = tr_read<v_rd_off(D0, 3, 0)>(vb), h3 = tr_read<v_rd_off(D0, 3, 1)>(vb);
  asm volatile("s_waitcnt lgkmcnt(0)" ::: "memory"); SBAR();
#define PK(L, H) (bf16x8){L[0], L[1], L[2], L[3], H[0], H[1], H[2], H[3]}
  od = __builtin_amdgcn_mfma_f32_32x32x16_bf16(pa0, PK(l0, h0), od, 0, 0, 0);
  od = __builtin_amdgcn_mfma_f32_32x32x16_bf16(pa1, PK(l1, h1), od, 0, 0, 0);
  od = __builtin_amdgcn_mfma_f32_32x32x16_bf16(pa2, PK(l2, h2), od, 0, 0, 0);
  od = __builtin_amdgcn_mfma_f32_32x32x16_bf16(pa3, PK(l3, h3), od, 0, 0, 0);
#undef PK
}
__device__ __forceinline__ void pv_d0(f32x16* o, int vb, bf16x8 pa0, bf16x8 pa1, bf16x8 pa2, bf16x8 pa3) {
  pv_one<0>(o[0], vb, pa0, pa1, pa2, pa3); pv_one<1>(o[1], vb, pa0, pa1, pa2, pa3); pv_one<2>(o[2], vb, pa0, pa1, pa2, pa3); pv_one<3>(o[3], vb, pa0, pa1, pa2, pa3);
}
__device__ __forceinline__ void body(const bf16_t* Qb, const bf16_t* __restrict__ Kh, const bf16_t* __restrict__ Vh, bf16_t* Ob, int seq, char* lds) {
  const int tid = threadIdx.x, wid = tid >> 6, lane = tid & 63, r32 = lane & 31, hi = lane >> 5;
  char* V_lds = lds; char* K_lds = lds + 2 * SHM_V;
  float* ws = (float*)(lds + 2 * SHM_V + 2 * SHM_K) + wid * 64; float* li_l = ws; float* al_l = ws + 32;
  float m_reg = -1e30f, l_reg = 0; f32x16 o[4] = {}; bf16x8 qr[8];
  const bf16_t* Qw = Qb + (long)(wid * QBLK + r32) * LDQ + hi * 8;
#pragma unroll
  for (int d0 = 0; d0 < 8; ++d0) qr[d0] = *reinterpret_cast<const bf16x8*>(Qw + d0 * 16);
  const int sr = tid >> 4, sc = (tid & 15) * 8, vst0 = v_st(sr, sc), vst1 = v_st(32 + sr, sc);
  const int vb0 = (int)(uintptr_t)V_lds + v_rd_base(lane);
  struct { bf16x8 vs0, vs1, ks0, ks1; } sr_[2];
#define SLOAD(i, k0) do { sr_[i].vs0 = *reinterpret_cast<const bf16x8*>(&Vh[(long)((k0) + sr) * LDK + sc]); sr_[i].vs1 = *reinterpret_cast<const bf16x8*>(&Vh[(long)((k0) + 32 + sr) * LDK + sc]); \
    sr_[i].ks0 = *reinterpret_cast<const bf16x8*>(&Kh[(long)((k0) + sr) * LDK + sc]); sr_[i].ks1 = *reinterpret_cast<const bf16x8*>(&Kh[(long)((k0) + 32 + sr) * LDK + sc]); } while (0)
#define SWRITE(b, i) do { *(bf16x8*)(V_lds + (b) * SHM_V + vst0) = sr_[i].vs0;          \
    *(bf16x8*)(V_lds + (b) * SHM_V + vst1) = sr_[i].vs1; int kc = sc * 2;               \
    *(bf16x8*)(K_lds + (b) * SHM_K + KSWZ(sr, kc)) = sr_[i].ks0;                       \
    *(bf16x8*)(K_lds + (b) * SHM_K + KSWZ(32 + sr, kc)) = sr_[i].ks1; } while (0)
#define SWAIT() asm volatile("s_waitcnt vmcnt(4)" ::: "memory")
#define RESC(a) do { if (__any((a) < 1.f)) { if (hi == 0) al_l[r32] = (a); asm volatile("s_waitcnt lgkmcnt(0)" ::: "memory"); \
    _Pragma("unroll") for (int d = 0; d < 4; ++d) _Pragma("unroll") for (int r = 0; r < 16; ++r) o[d][r] *= al_l[crow(r, hi)]; } } while (0)
  f32x16 pA0, pA1, pB0, pB1; float mnA, mnB, alA, alB; bf16x8 pa0, pa1, pa2, pa3; const int NT = seq / KVBLK;
  constexpr int SE = 0, SO = 1;
  SLOAD(SE, 0); asm volatile("s_waitcnt vmcnt(0)" ::: "memory"); SWRITE(0, SE); __syncthreads();
  qkt(pA0, pA1, K_lds, qr, r32, hi); partialSM(pA0, pA1, m_reg, mnA, alA);
  SLOAD(SO, KVBLK); if (2 < NT) SLOAD(SE, 2 * KVBLK);
  SWAIT(); SWRITE(1, SO); __syncthreads();
  for (int j = 1; j + 1 < NT; j += 2) {
    SBAR(); qkt(pB0, pB1, K_lds + SHM_K, qr, r32, hi);
    finishSM(pA0, pA1, alA, l_reg, pa0, pa1, pa2, pa3); SBAR();
    SLOAD(SO, (j + 2) * KVBLK); SBAR();
    pv_d0(o, vb0, pa0, pa1, pa2, pa3); partialSM(pB0, pB1, m_reg, mnB, alB);
    __syncthreads(); SWAIT(); SWRITE(0, SE);
    RESC(alB); __syncthreads();
    SBAR(); qkt(pA0, pA1, K_lds, qr, r32, hi);
    finishSM(pB0, pB1, alB, l_reg, pa0, pa1, pa2, pa3); SBAR();
    if (j + 3 < NT) SLOAD(SE, (j + 3) * KVBLK); SBAR();
    pv_d0(o, vb0 + (int)SHM_V, pa0, pa1, pa2, pa3); partialSM(pA0, pA1, m_reg, mnA, alA);
    __syncthreads(); SWAIT(); SWRITE(1, SO);
    RESC(alA); __syncthreads();
  }
  SBAR(); qkt(pB0, pB1, K_lds + SHM_K, qr, r32, hi);
  finishSM(pA0, pA1, alA, l_reg, pa0, pa1, pa2, pa3); SBAR();
  pv_d0(o, vb0, pa0, pa1, pa2, pa3); partialSM(pB0, pB1, m_reg, mnB, alB);
  __syncthreads(); RESC(alB);
  finishSM(pB0, pB1, alB, l_reg, pa0, pa1, pa2, pa3); SBAR();
  pv_d0(o, vb0 + (int)SHM_V, pa0, pa1, pa2, pa3);
  if (hi == 0) li_l[r32] = l_reg; asm volatile("s_waitcnt lgkmcnt(0)" ::: "memory");
  float rli[16];
#pragma unroll
  for (int r = 0; r < 16; ++r) rli[r] = __builtin_amdgcn_rcpf(li_l[crow(r, hi)]);
  bf16_t* Ow = Ob + (long)(wid * QBLK) * LDO;
#pragma unroll
  for (int r = 0; r < 16; ++r) { int orow = crow(r, hi);
#pragma unroll
    for (int d0 = 0; d0 < 4; ++d0) Ow[(long)orow * LDO + d0 * 32 + r32] = (bf16_t)f2bf(o[d0][r] * rli[r]); }
  __syncthreads();
#undef SLOAD
#undef SWRITE
#undef SWAIT
#undef RESC
}
#undef KSWZ
#undef SBAR
}

__device__ __forceinline__ void p4_mixers(Frame& F) {
    for (int u = blockIdx.x; u < NB * 8; u += F.G) ml::unit(F, u >> 3, u & 7);
    volatile LAS int* qslot = (volatile LAS int*)(F.lds + MISC_OFF + 64);
    bf16_t* AQ = (bf16_t*)(F.ws + WS_AQ); const bf16_t* AK = (const bf16_t*)(F.ws + WS_AK); const bf16_t* AV = (const bf16_t*)(F.ws + WS_AV);
    for (;;) {
        if (F.tid == 0) *qslot = (int)__hip_atomic_fetch_add((unsigned*)(F.ctl + CW_ATTQ), 1u, RLX_AGENT);
        __syncthreads();
        const int idx = *qslot;
        __syncthreads();
        if (idx >= NB * 8 * 8) break;
        const int b = idx >> 6, kvh = (idx >> 5) & 1, g = (idx >> 3) & 3, qb = idx & 7, head = kvh * 4 + g;
        bf16_t* Q = AQ + (size_t)(b * SEQ + qb * 256) * D + head * 128;
        const bf16_t* K = AK + (size_t)(b * KVL) * 256 + kvh * 128; const bf16_t* V = AV + (size_t)(b * KVL) * 256 + kvh * 128;
        at::body(Q, K, V, Q, KVL, (char*)F.lds);
    }
}

struct RectOrder { static constexpr bool GATHER = false; const char* A; const char* Bt; int nM, nN, K, G, c;
    __device__ __forceinline__ bool next(int i, pg8::Unit& u) const { const long L = (long)i * G + c; if (L >= nM * nN) return false; pg8::tile_of((int)L, nM, nN, u.pm, u.pn); u.x0 = 0; u.x1 = 0; return true; }
    __device__ __forceinline__ const char* aptr(const pg8::Unit& u) const { return A + (size_t)u.pm * 256 * K * 2; }
    __device__ __forceinline__ const char* bptr(const pg8::Unit& u) const { return Bt + (size_t)u.pn * 256 * K * 2; }
    __device__ __forceinline__ void aoff(const pg8::Unit&, int, unsigned (&)[2][2]) const {}
};
template <int PASS> struct EpiMerge { static constexpr bool PERM = true; const bf16_t* mg; bf16_t* Z;
    __device__ __forceinline__ void operator()(const f32x4 (&acc)[2][2][4][2], const pg8::Unit& u, int wr, int wc, int fr, int fq) const {
        const int row0 = u.pm * 256 + wr * 64 + fr, col0 = u.pn * 256 + wc * 32 + 8 * fq;
#pragma unroll
        for (int ai = 0; ai < 2; ++ai)
#pragma unroll
            for (int m = 0; m < 4; ++m) { const size_t row = (size_t)(row0 + ai * 128 + m * 16);
#pragma unroll
                for (int bj = 0; bj < 2; ++bj) { const int col = col0 + bj * 128;
                    const u32x4 gw = *(const GAS u32x4*)(mg + row * (2 * D) + PASS * D + col);
                    const f32x4 v0 = acc[ai][bj][m][0], v1 = acc[ai][bj][m][1];
                    float z[8] = { sigmoidf_(bflo(gw.x)) * v0[0], sigmoidf_(bfhi(gw.x)) * v0[1], sigmoidf_(bflo(gw.y)) * v0[2], sigmoidf_(bfhi(gw.y)) * v0[3],
                                   sigmoidf_(bflo(gw.z)) * v1[0], sigmoidf_(bfhi(gw.z)) * v1[1], sigmoidf_(bflo(gw.w)) * v1[2], sigmoidf_(bfhi(gw.w)) * v1[3] };
                    bf16_t* zp = Z + row * D + col;
                    if (PASS == 1) { const u32x4 zw = *(const GAS u32x4*)zp;
                        z[0] += bflo(zw.x); z[1] += bfhi(zw.x); z[2] += bflo(zw.y); z[3] += bfhi(zw.y); z[4] += bflo(zw.z); z[5] += bfhi(zw.z); z[6] += bflo(zw.w); z[7] += bfhi(zw.w); }
                    u32x4 w; w.x = cvt_pk_bf16(z[0], z[1]); w.y = cvt_pk_bf16(z[2], z[3]); w.z = cvt_pk_bf16(z[4], z[5]); w.w = cvt_pk_bf16(z[6], z[7]);
                    *(GAS u32x4*)zp = w; }
                asm volatile("" ::: "memory"); }
    }
};
struct EpiOut { static constexpr bool PERM = false; const float* x; const float* mod; float* out;
    __device__ __forceinline__ void operator()(const f32x4 (&acc)[2][2][4][2], const pg8::Unit& u, int wr, int wc, int fr, int fq) const {
        const int row0 = u.pm * 256 + wr * 64 + fr, col0 = u.pn * 256 + wc * 32 + 4 * fq; const float* g1 = mod + (size_t)((u.pm * 256) / SEQ) * NMOD + 2 * D;
#pragma unroll
        for (int ai = 0; ai < 2; ++ai)
#pragma unroll
            for (int m = 0; m < 4; ++m) { const size_t ro = (size_t)(row0 + ai * 128 + m * 16) * D;
#pragma unroll
                for (int bj = 0; bj < 2; ++bj)
#pragma unroll
                    for (int n = 0; n < 2; ++n) { const int col = col0 + bj * 128 + n * 16;
                        const f32x4 xv = *(const GAS f32x4*)(x + ro + col), gv = *(const f32x4*)(g1 + col);
                        *(GAS f32x4*)(out + ro + col) = xv + gv * acc[ai][bj][m][n]; }
                asm volatile("" ::: "memory"); }
    }
};

struct DrGU { int up; __device__ __forceinline__ int operator()(int j) const { return 256 * (j >> 7) + 128 * ((j >> 6) & 1) + 32 * ((j >> 4) & 3) + 8 * ((j >> 2) & 3) + 4 * up + (j & 3); } };
__device__ __forceinline__ void p8_router(Frame& F) {
    const int gw = F.vcu * NWAVES + F.wave, NGW = F.G * NWAVES;
    {
        LAS float* scr = (LAS float*)(F.lds + F.wave * 16384);
        bf16_t* wgu = (bf16_t*)(F.ws + WS_WGU); bf16_t* wd = (bf16_t*)(F.ws + WS_WD);
        constexpr int I_G = 16 * 8, I_D = 4 * 32, PER_E = 2 * I_G + I_D;
        for (int it = gw; it < NEXP * PER_E; it += NGW) { const int e = it / PER_E; int r = it % PER_E;
            if (r < I_G) { transpose_item(F.in[IN_WEG] + (size_t)e * D * DEXP, D, DEXP, wgu + (size_t)e * 512 * D, DrGU{0}, scr, r, F.lane); continue; } r -= I_G;
            if (r < I_G) { transpose_item(F.in[IN_WEU] + (size_t)e * D * DEXP, D, DEXP, wgu + (size_t)e * 512 * D, DrGU{1}, scr, r, F.lane); continue; } r -= I_G;
            transpose_item(F.in[IN_WED] + (size_t)e * DEXP * D, DEXP, D, wd + (size_t)e * D * DEXP, DrIdent{0}, scr, r, F.lane); }
    }
    __syncthreads();
    LAS float* WrT = (LAS float*)F.lds;
    { const float* wrg = F.in[IN_WRG]; const float* wre = F.in[IN_WRE];
      for (int i = F.tid; i < 1024 * 4; i += NTHREADS) WrT[(i & 3) * 1024 + (i >> 2)] = wrg[i];
      for (int i = F.tid; i < 1024 * 32; i += NTHREADS) WrT[(4 + (i & 31)) * 1024 + (i >> 5)] = wre[i]; }
    __syncthreads();
    const float* mod = (const float*)(F.ws + WS_MOD); const float* n2w = F.in[IN_N2W]; bf16_t* FL = (bf16_t*)(F.ws + WS_FL);
    const float* brg = F.in[IN_BRG]; const float* bre = F.in[IN_BRE];
    unsigned* eid = (unsigned*)(F.ws + WS_ROUT); float* wts = (float*)(F.ws + WS_ROUT) + 2 * T_LAT; unsigned* lists = (unsigned*)(F.ws + WS_LISTS);
    for (int row = gw; row < T_LAT; row += NGW) {
        const int b = row / SEQ;
        const GAS f32x4* hr = (const GAS f32x4*)(F.out + (size_t)row * D) + F.lane;
        f32x4 v[4]; float s = 0.f;
#pragma unroll
        for (int j = 0; j < 4; ++j) { v[j] = hr[64 * j]; s += (v[j].x * v[j].x + v[j].y * v[j].y) + (v[j].z * v[j].z + v[j].w * v[j].w); }
        const float rinv = 1.0f / sqrtf(wave_sum(s) * (1.0f / D) + EPS);
        GAS u32x2* o8 = (GAS u32x2*)(FL + (size_t)row * D) + F.lane;
#pragma unroll
        for (int j = 0; j < 4; ++j) { const int col = 256 * j + 4 * F.lane;
            const f32x4 w = *(const f32x4*)(n2w + col), sh = *(const f32x4*)(mod + b * NMOD + 3 * D + col), sc = *(const f32x4*)(mod + b * NMOD + 4 * D + col);
            v[j] = (v[j] * rinv) * w * (sc + 1.0f) + sh;
            u32x2 o; o.x = pk2(v[j].x, v[j].y); o.y = pk2(v[j].z, v[j].w); o8[64 * j] = o; }
        LAS float* lgs = (LAS float*)(F.lds + MISC_OFF + 1024 + F.wave * 256);
#pragma unroll 2
        for (int o = 0; o < 36; ++o) { float a = 0.f;
#pragma unroll
            for (int j = 0; j < 4; ++j) { const f32x4 wv = *(const LAS f32x4*)(WrT + o * 1024 + 256 * j + 4 * F.lane); a += (v[j].x * wv.x + v[j].y * wv.y) + (v[j].z * wv.z + v[j].w * wv.w); }
            a = wave_sum(a); if (F.lane == 0) lgs[o] = a; }
        LDS_WAIT(); asm volatile("" ::: "memory");
        float lg[36];
#pragma unroll
        for (int o = 0; o < 36; ++o) lg[o] = lgs[o];
        float gl[4];
#pragma unroll
        for (int g = 0; g < 4; ++g) gl[g] = lg[g] + brg[g];
        int gs = 0; float gm = gl[0];
#pragma unroll
        for (int g = 1; g < 4; ++g) if (gl[g] > gm) { gm = gl[g]; gs = g; }
        float den = 0.f;
#pragma unroll
        for (int g = 0; g < 4; ++g) den += expf(gl[g] - gm);
        const float pgrp = 1.0f / den;
        float el[8];
#pragma unroll
        for (int j = 0; j < 8; ++j) { el[j] = lg[4 + j] + bre[j];
#pragma unroll
            for (int g = 1; g < 4; ++g) el[j] = (gs == g) ? lg[4 + 8 * g + j] + bre[8 * g + j] : el[j]; }
        int i0 = 0; float v0 = el[0];
#pragma unroll
        for (int j = 1; j < 8; ++j) if (el[j] > v0) { v0 = el[j]; i0 = j; }
        int i1 = -1; float v1 = -3.0e38f;
#pragma unroll
        for (int j = 0; j < 8; ++j) if (j != i0 && el[j] > v1) { v1 = el[j]; i1 = j; }
        const float e1 = expf(v1 - v0), w0 = pgrp / (1.0f + e1), w1 = pgrp * e1 / (1.0f + e1);
        if (F.lane == 0) {
            const int ex0 = gs * 8 + i0, ex1 = gs * 8 + i1;
            const unsigned p0 = __hip_atomic_fetch_add((unsigned*)(F.ctl + CW_CNT + ex0 * 64), 1u, RLX_AGENT);
            const unsigned p1 = __hip_atomic_fetch_add((unsigned*)(F.ctl + CW_CNT + (32 + ex1) * 64), 1u, RLX_AGENT);
            lists[(size_t)ex0 * T_LAT + p0] = (unsigned)row; lists[(size_t)(32 + ex1) * T_LAT + p1] = (unsigned)row;
            eid[row] = (unsigned)ex0; eid[T_LAT + row] = (unsigned)ex1; wts[row] = w0; wts[T_LAT + row] = w1;
        }
    }
}

__device__ __forceinline__ void moe_table(Frame& F) {
    volatile LAS int* ts = (volatile LAS int*)(F.lds + MISC_OFF + 256); volatile LAS int* cn = ts + 80;
    if (F.tid < 64) cn[F.tid] = (int)__hip_atomic_load((unsigned*)(F.ctl + CW_CNT + F.tid * 64), RLX_AGENT);
    __syncthreads();
    if (F.tid == 0) { int a = 0; for (int g = 0; g < 64; ++g) { ts[g] = a; a += (cn[g] + 255) >> 8; } ts[64] = a; }
    __syncthreads();
}
struct Moe1Order { static constexpr bool GATHER = true; const char* FLb; const char* Wgu; const unsigned* lists; const LAS int* ts; const LAS int* cn; int G, c;
    __device__ __forceinline__ bool next(int i, pg8::Unit& u) const { const long L = (long)i * G + c; const int T = (int)(L >> 1); if (T >= ts[64]) return false;
        int g = 0; while (ts[g + 1] <= T) ++g;
        u.pm = T; u.pn = (int)(L & 1); u.x0 = g; u.x1 = (T - ts[g]) * 256; return true; }
    __device__ __forceinline__ const char* aptr(const pg8::Unit&) const { return FLb; }
    __device__ __forceinline__ const char* bptr(const pg8::Unit& u) const { return Wgu + ((size_t)(u.x0 & 31) * 512 + (size_t)u.pn * 256) * D * 2; }
    __device__ __forceinline__ void aoff(const pg8::Unit& u, int tid, unsigned (&off)[2][2]) const { const int n = cn[u.x0];
#pragma unroll
        for (int i = 0; i < 2; ++i) { int R, C; pg8::stage_rc(tid * 16 + i * 8192, R, C);
#pragma unroll
            for (int h = 0; h < 2; ++h) { const int idx = u.x1 + h * 128 + R; const unsigned tok = idx < n ? lists[(size_t)u.x0 * T_LAT + idx] : 0u; off[h][i] = tok * (unsigned)(D * 2) + (unsigned)(C * 2); } } }
};
struct EpiMoe1 { static constexpr bool PERM = true; bf16_t* H;
    __device__ __forceinline__ void operator()(const f32x4 (&acc)[2][2][4][2], const pg8::Unit& u, int wr, int wc, int fr, int fq) const {
        const int row0 = u.pm * 256 + wr * 64 + fr, col0 = u.pn * 128 + 16 * wc + 4 * fq;
#pragma unroll
        for (int ai = 0; ai < 2; ++ai)
#pragma unroll
            for (int m = 0; m < 4; ++m)
#pragma unroll
                for (int bj = 0; bj < 2; ++bj) { const f32x4 g = acc[ai][bj][m][0], up = acc[ai][bj][m][1];
                    u32x2 w; w.x = cvt_pk_bf16(siluf_(g[0]) * up[0], siluf_(g[1]) * up[1]); w.y = cvt_pk_bf16(siluf_(g[2]) * up[2], siluf_(g[3]) * up[3]);
                    *(GAS u32x2*)(H + (size_t)(row0 + ai * 128 + m * 16) * DEXP + col0 + 64 * bj) = w; }
    }
};
struct Moe2Order { static constexpr bool GATHER = false; const char* Hb; const char* Wd; const LAS int* ts; const LAS int* cn; int slot, G, c;
    __device__ __forceinline__ bool next(int i, pg8::Unit& u) const { const long L = (long)i * G + c; const int T = ts[slot * 32] + (int)(L >> 2); if (T >= ts[slot * 32 + 32]) return false;
        int g = slot * 32; while (ts[g + 1] <= T) ++g;
        u.pm = T; u.pn = (int)(L & 3); u.x0 = g; u.x1 = (T - ts[g]) * 256; return true; }
    __device__ __forceinline__ const char* aptr(const pg8::Unit& u) const { return Hb + (size_t)u.pm * 256 * DEXP * 2; }
    __device__ __forceinline__ const char* bptr(const pg8::Unit& u) const { return Wd + ((size_t)(u.x0 & 31) * D + (size_t)u.pn * 256) * DEXP * 2; }
    __device__ __forceinline__ void aoff(const pg8::Unit&, int, unsigned (&)[2][2]) const {}
};
struct EpiMoe2 { static constexpr bool PERM = false; float* out; const float* mod; const unsigned* lists; const float* wts; const LAS int* cn; int slot;
    __device__ __forceinline__ void operator()(const f32x4 (&acc)[2][2][4][2], const pg8::Unit& u, int wr, int wc, int fr, int fq) const {
        const int n = cn[u.x0], col0 = u.pn * 256 + wc * 32 + 4 * fq;
#pragma unroll
        for (int ai = 0; ai < 2; ++ai)
#pragma unroll
            for (int m = 0; m < 4; ++m) { const int idx = u.x1 + ai * 128 + wr * 64 + m * 16 + fr;
                if (idx < n) { const unsigned tok = lists[(size_t)u.x0 * T_LAT + idx]; const float w = wts[(size_t)slot * T_LAT + tok]; const float* g2 = mod + (size_t)(tok / SEQ) * NMOD + 5 * D; float* op = out + (size_t)tok * D;
#pragma unroll
                    for (int bj = 0; bj < 2; ++bj)
#pragma unroll
                        for (int nn = 0; nn < 2; ++nn) { const int col = col0 + bj * 128 + nn * 16; const f32x4 gv = *(const f32x4*)(g2 + col); const f32x4 ov = *(const GAS f32x4*)(op + col);
                            *(GAS f32x4*)(op + col) = ov + (gv * w) * acc[ai][bj][m][nn]; } }
                asm volatile("" ::: "memory"); }
    }
};

#ifndef MK_N_LAUNCHES
#define MK_N_LAUNCHES 1
#endif
constexpr int N_PHASES = 12;
constexpr int N_LAUNCHES = MK_N_LAUNCHES;
struct Args { const float* in[23]; float* out; unsigned char* ws; int ph_lo, ph_hi, kd, pad; };
__global__ void __launch_bounds__(NTHREADS, 2) fwd_kernel(Args args) {
    extern __shared__ __attribute__((aligned(16))) unsigned char lds[];
    Frame F;
    F.lds = (LAS unsigned char*)lds;
    F.tid = threadIdx.x; F.lane = F.tid & 63; F.wave = __builtin_amdgcn_readfirstlane(F.tid >> 6);
    F.G = gridDim.x; { const int bx = blockIdx.x; F.vcu = (F.G % 8 == 0) ? (bx % 8) * (F.G / 8) + bx / 8 : bx; }
    F.ws = args.ws; F.out = args.out; F.ctl = (gu32*)(args.ws + WS_CTL);
#pragma unroll
    for (int i = 0; i < 23; ++i) F.in[i] = args.in[i];
    for (int u = F.tid; u < (LDS_BYTES - MISC_OFF) / 4; u += NTHREADS) ((LAS unsigned*)(F.lds + MISC_OFF))[u] = 0u;
    __syncthreads();
    XcdBarrier bar; bar.bar = (unsigned*)(F.ctl + CW_BAR); bar.x = 0; bar.st = nullptr;
    if (N_LAUNCHES == 1) bar = xcd_barrier_post((unsigned*)(F.ctl + CW_BAR), (volatile LAS unsigned*)(F.lds + MISC_OFF + 32));
    const int lo = args.ph_lo, hi = args.ph_hi;
#ifndef PH_MASK
#define PH_MASK 0xFFF
#endif
#define IN(k) ((((PH_MASK) >> (k)) & 1) && lo <= (k) && (k) < hi)
#define SEAM(k) do { if (IN(k) && IN((k) + 1)) xcd_barrier(bar); } while (0)

    if (IN(0)) { p0_prologue(F); } SEAM(0);
    if (IN(1)) { p1_a0(F); } SEAM(1);
    if (IN(2)) {
        InProjOrder S{(const char*)(F.ws + WS_A0), (const char*)(F.ws + WS_WIN), F.G, (int)blockIdx.x};
        EpiInProj E{F.ws, (bf16_t*)F.out, F.in[IN_BMG]};
        pg8::gemm_phase<EpiInProj, InProjOrder, true>(F.lds, D, S, E);
    } SEAM(2);
    if (IN(3)) { p3_qknorm(F); } SEAM(3);
    if (IN(4)) { p4_mixers(F); } SEAM(4);
    if (IN(5)) {
        RectOrder S{(const char*)(F.ws + WS_MQ), (const char*)(F.ws + WS_WBM), MT_LAT, 4, D, F.G, (int)blockIdx.x};
        EpiMerge<0> E{(const bf16_t*)F.out, (bf16_t*)(F.ws + WS_Z)};
        pg8::gemm_phase<EpiMerge<0>, RectOrder, true>(F.lds, D, S, E);
    } SEAM(5);
    if (IN(6)) {
        RectOrder S{(const char*)(F.ws + WS_AQ), (const char*)(F.ws + WS_WBA), MT_LAT, 4, D, F.G, (int)blockIdx.x};
        EpiMerge<1> E{(const bf16_t*)F.out, (bf16_t*)(F.ws + WS_Z)};
        pg8::gemm_phase<EpiMerge<1>, RectOrder, true>(F.lds, D, S, E);
    } SEAM(6);
    if (IN(7)) {
        RectOrder S{(const char*)(F.ws + WS_Z), (const char*)(F.ws + WS_WO), MT_LAT, 4, D, F.G, (int)blockIdx.x};
        EpiOut E{F.in[IN_X], (const float*)(F.ws + WS_MOD), F.out};
        pg8::gemm_phase<EpiOut, RectOrder, true>(F.lds, D, S, E);
    } SEAM(7);
    if (IN(8)) { p8_router(F); } SEAM(8);
    if (IN(9)) {
        moe_table(F);
        const LAS int* ts = (const LAS int*)(F.lds + MISC_OFF + 256);
        Moe1Order S{(const char*)(F.ws + WS_FL), (const char*)(F.ws + WS_WGU), (const unsigned*)(F.ws + WS_LISTS), ts, ts + 80, F.G, (int)blockIdx.x};
        EpiMoe1 E{(bf16_t*)(F.ws + WS_H)};
        pg8::gemm_phase<EpiMoe1, Moe1Order, true>(F.lds, D, S, E);
    } SEAM(9);
    if (IN(10)) {
        moe_table(F);
        const LAS int* ts = (const LAS int*)(F.lds + MISC_OFF + 256);
        Moe2Order S{(const char*)(F.ws + WS_H), (const char*)(F.ws + WS_WD), ts, ts + 80, 0, F.G, (int)blockIdx.x};
        EpiMoe2 E{F.out, (const float*)(F.ws + WS_MOD), (const unsigned*)(F.ws + WS_LISTS), (const float*)(F.ws + WS_ROUT) + 2 * T_LAT, ts + 80, 0};
        pg8::gemm_phase<EpiMoe2, Moe2Order, true>(F.lds, args.kd, S, E);
    } SEAM(10);
    if (IN(11)) {
        moe_table(F);
        const LAS int* ts = (const LAS int*)(F.lds + MISC_OFF + 256);
        Moe2Order S{(const char*)(F.ws + WS_H), (const char*)(F.ws + WS_WD), ts, ts + 80, 1, F.G, (int)blockIdx.x};
        EpiMoe2 E{F.out, (const float*)(F.ws + WS_MOD), (const unsigned*)(F.ws + WS_LISTS), (const float*)(F.ws + WS_ROUT) + 2 * T_LAT, ts + 80, 1};
        pg8::gemm_phase<EpiMoe2, Moe2Order, true>(F.lds, args.kd, S, E);
    }
#undef IN
#undef SEAM
}

extern "C" void kernel_launch(void* const* d_in, const int* in_sizes, int n_in, void* d_out, int out_size, void* d_ws, size_t ws_size, hipStream_t stream) {
    static int grid = 0;
    if (grid == 0) {
        if (n_in != 23 || out_size != T_LAT * D || ws_size < WS_END) { fprintf(stderr, "kernel_launch: unexpected shapes (n_in %d out %d ws %zu)\n", n_in, out_size, ws_size); grid = -1; return; }
        int dev = 0, cus = 0;
        if (hipGetDevice(&dev) != hipSuccess || hipDeviceGetAttribute(&cus, hipDeviceAttributeMultiprocessorCount, dev) != hipSuccess) { grid = -1; return; }
        if (hipFuncSetAttribute((const void*)fwd_kernel, hipFuncAttributeMaxDynamicSharedMemorySize, LDS_BYTES) != hipSuccess) { fprintf(stderr, "kernel_launch: hipFuncSetAttribute failed\n"); grid = -1; return; }
        int per_cu = 0;
        if (hipOccupancyMaxActiveBlocksPerMultiprocessor(&per_cu, (const void*)fwd_kernel, NTHREADS, LDS_BYTES) != hipSuccess || per_cu < 1) fprintf(stderr, "kernel_launch: occupancy query says %d\n", per_cu);
        (void)hipGetLastError();
        grid = cus;
    }
    if (grid < 0) return;
    if (hipMemsetAsync((char*)d_ws + WS_CTL, 0, CTL_ZERO_BYTES, stream) != hipSuccess) return;
    Args a{};
    for (int i = 0; i < 23; ++i) a.in[i] = (const float*)d_in[i];
    a.out = (float*)d_out; a.ws = (unsigned char*)d_ws; a.kd = DEXP; a.pad = 0;
    if (N_LAUNCHES == 1) { a.ph_lo = 0; a.ph_hi = N_PHASES; hipLaunchKernelGGL(fwd_kernel, dim3(grid), dim3(NTHREADS), LDS_BYTES, stream, a); }
    else for (int p = 0; p < N_PHASES; ++p) { a.ph_lo = p; a.ph_hi = p + 1; hipLaunchKernelGGL(fwd_kernel, dim3(grid), dim3(NTHREADS), LDS_BYTES, stream, a); }
    const hipError_t le = hipPeekAtLastError();
    if (le != hipSuccess) fprintf(stderr, "kernel_launch: launch failed: %s\n", hipGetErrorName(le));
}
```

```cpp
#include <hip/hip_runtime.h>
#include <cstdio>
#include <cstdint>

#define LAS __attribute__((address_space(3)))
#define GAS __attribute__((address_space(1)))
typedef unsigned short bf16_t;
typedef short bf16x8 __attribute__((ext_vector_type(8)));
typedef short s16x4 __attribute__((ext_vector_type(4)));
typedef float f32x4 __attribute__((ext_vector_type(4)));
typedef float f32x2 __attribute__((ext_vector_type(2)));
typedef float f32x16 __attribute__((ext_vector_type(16)));
typedef unsigned u32x4 __attribute__((ext_vector_type(4)));
typedef unsigned u32x2 __attribute__((ext_vector_type(2)));
typedef GAS unsigned gu32;

constexpr int D = 1024, NB = 16, SEQ = 2048, CTXL = 256;
constexpr int T_LAT = NB * SEQ, T_CTX = NB * CTXL, T_ALL = T_LAT + T_CTX;
constexpr int IN_W = 7712, NMOD = 6 * D;
constexpr int KVL = SEQ + CTXL;
constexpr int NEXP = 32, DEXP = 256;
constexpr float EPS = 1e-6f;
constexpr int NWAVES = 8, NTHREADS = 512;

constexpr int NT_LAT = 31, NT_CTX = 11, NW_IN = NT_LAT * 256;
constexpr int MT_LAT = T_LAT / 256, MT_CTX = T_CTX / 256;

constexpr size_t MiB = 1u << 20;
constexpr size_t WS_CTL = 0, CTL_ZERO_BYTES = 1 * MiB;
constexpr size_t WS_MOD = 1 * MiB;
constexpr size_t WS_ROPE = 1 * MiB + 512 * 1024;
constexpr size_t WS_GATES = 2 * MiB;
constexpr size_t WS_WBM = 7 * MiB, WS_WO = 11 * MiB;
constexpr size_t WS_WR = 28 * MiB + 512 * 1024;
constexpr size_t WS_WIN = 13 * MiB;
constexpr size_t WS_ROUT = 29 * MiB;
constexpr size_t WS_LISTS = 30 * MiB;
constexpr size_t WS_A0 = 38 * MiB;
constexpr size_t WS_MQ = 110 * MiB;
constexpr size_t WS_MK = 174 * MiB;
constexpr size_t WS_MV = 246 * MiB;
constexpr size_t WS_OG = 318 * MiB;
constexpr size_t WS_AQ = 382 * MiB;
constexpr size_t WS_AK = 446 * MiB;
constexpr size_t WS_AV = 464 * MiB;
constexpr size_t WS_END = 482 * MiB;
constexpr size_t WS_WGU = WS_A0, WS_WD = WS_A0 + 32 * MiB;
constexpr size_t WS_Z = WS_MK, WS_FL = WS_MV, WS_H = WS_OG, WS_HTMP = WS_A0;
constexpr size_t WS_LG = WS_AK;

constexpr int CW_TMO = 0, CW_ATTQ = 64, CW_BAR = 4096;
constexpr int CW_CNT = 8192;
constexpr int LDS_BYTES = 155648;
constexpr int MISC_OFF = 147456;

#define RLX_AGENT __ATOMIC_RELAXED, __HIP_MEMORY_SCOPE_AGENT
#define LDS_WAIT() asm volatile("s_waitcnt lgkmcnt(0)" ::: "memory")
#define VM_WAIT() asm volatile("s_waitcnt vmcnt(0)" ::: "memory")

__device__ __forceinline__ unsigned f2bf(float f) { unsigned u = __builtin_bit_cast(unsigned, f); return (u + 0x7fffu + ((u >> 16) & 1u)) >> 16; }
__device__ __forceinline__ unsigned pk2(float lo, float hi) { return f2bf(lo) | (f2bf(hi) << 16); }
__device__ __forceinline__ float bf2f(unsigned short b) { return __builtin_bit_cast(float, ((unsigned)b) << 16); }
__device__ __forceinline__ float bflo(unsigned w) { return __builtin_bit_cast(float, w << 16); }
__device__ __forceinline__ float bfhi(unsigned w) { return __builtin_bit_cast(float, w & 0xffff0000u); }
__device__ __forceinline__ unsigned cvt_pk_bf16(float lo, float hi) { unsigned r; asm volatile("v_cvt_pk_bf16_f32 %0, %1, %2" : "=v"(r) : "v"(lo), "v"(hi)); return r; }
__device__ __forceinline__ float wave_sum(float v) {
#pragma unroll
    for (int o = 1; o < 64; o <<= 1) v += __shfl_xor(v, o);
    return v;
}
__device__ __forceinline__ float wave_max(float v) {
#pragma unroll
    for (int o = 1; o < 64; o <<= 1) v = fmaxf(v, __shfl_xor(v, o));
    return v;
}
__device__ __forceinline__ float sigmoidf_(float x) { return 1.0f / (1.0f + __expf(-x)); }
__device__ __forceinline__ float siluf_(float x) { return x / (1.0f + __expf(-x)); }

#define XB_TMO      128
#define XB_XCNT(j)  (256  + 64 * (j))
#define XB_XSUB(j)  (1280 + 64 * (j))
#define XB_XGEN(j)  (2304 + 64 * (j))
#define XB_TOP      3328
#define XB_TOPGEN   3392
#define XCD_BAR_WORDS 3456
#define XB_SPIN_CAP (1u << 18)

__device__ __forceinline__ unsigned xb_ld(unsigned* p)              { return __hip_atomic_load(p, __ATOMIC_RELAXED, __HIP_MEMORY_SCOPE_AGENT); }
__device__ __forceinline__ unsigned xb_add(unsigned* p, unsigned v) { return __hip_atomic_fetch_add(p, v, __ATOMIC_RELAXED, __HIP_MEMORY_SCOPE_AGENT); }
__device__ __forceinline__ unsigned xb_xcc_id() { return (unsigned)__builtin_amdgcn_s_getreg((3 << 11) | 20) & 0xFu; }
#define XB_SPIN(cond, bar) do { unsigned _sp = 0; while (cond) { __builtin_amdgcn_s_sleep(1); \
    if ((++_sp & 255u) == 0u) { if (xb_ld(&(bar)[XB_TMO])) break; if (_sp > XB_SPIN_CAP) { atomicAdd(&(bar)[XB_TMO], 1u); break; } } } } while (0)

struct XcdBarrier {
    unsigned* bar; unsigned x;
    volatile LAS unsigned* st;
};

__device__ __forceinline__ XcdBarrier xcd_barrier_post(unsigned* bar, volatile LAS unsigned* st) {
    XcdBarrier b; b.bar = bar; b.x = xb_xcc_id(); b.st = st;
    if (threadIdx.x == 0) (void)xb_add(&bar[XB_XCNT(b.x)], 1u);
    return b;
}
__device__ __forceinline__ void xcd_barrier_complete(unsigned* bar, unsigned x, unsigned& nloc, unsigned& nx) {
    const unsigned G = gridDim.x * gridDim.y * gridDim.z;
    unsigned sum, cnt, mine, sp = 0u;
    for (;;) {
        sum = 0u; cnt = 0u; mine = 0u;
#pragma unroll
        for (unsigned j = 0; j < 16; ++j) { const unsigned c = xb_ld(&bar[XB_XCNT(j)]); sum += c; cnt += (c > 0u) ? 1u : 0u; mine = (j == x) ? c : mine; }
        if (sum == G) break;
        __builtin_amdgcn_s_sleep(1);
        if ((++sp & 255u) == 0u) { if (xb_ld(&bar[XB_TMO])) break; if (sp > XB_SPIN_CAP) { atomicAdd(&bar[XB_TMO], 1u); break; } }
    }
    nloc = mine > 0u ? mine : 1u; nx = cnt > 0u ? cnt : 1u;
}

__device__ __forceinline__ void xcd_barrier(const XcdBarrier& b) {
    asm volatile("s_waitcnt vmcnt(0)" ::: "memory");
    __syncthreads();
    if (threadIdx.x == 0) {
        unsigned* bar = b.bar;
        __builtin_amdgcn_s_waitcnt(0);
        unsigned nloc = b.st[0], nx = b.st[1];
        if (nloc == 0u) { xcd_barrier_complete(bar, b.x, nloc, nx); b.st[0] = nloc; b.st[1] = nx; }
        const unsigned old = xb_add(&bar[XB_XSUB(b.x)], 1u);
        const unsigned gen = old / nloc;
        if (old + 1u == (gen + 1u) * nloc) {
            __builtin_amdgcn_fence(__ATOMIC_RELEASE, "agent");
            asm volatile("s_waitcnt vmcnt(0)" ::: "memory");
            const unsigned og = xb_add(&bar[XB_TOP], 1u);
            const unsigned tg = og / nx;
            if (og + 1u == (tg + 1u) * nx) xb_add(&bar[XB_TOPGEN], 1u);
            else XB_SPIN(xb_ld(&bar[XB_TOPGEN]) == tg, bar);
            __builtin_amdgcn_fence(__ATOMIC_ACQUIRE, "agent");
            xb_add(&bar[XB_XGEN(b.x)], 1u);
            asm volatile("s_waitcnt vmcnt(0)" ::: "memory");
        } else {
            XB_SPIN(xb_ld(&bar[XB_XGEN(b.x)]) == gen, bar);
            __builtin_amdgcn_fence(__ATOMIC_ACQUIRE, "agent");
            asm volatile("s_waitcnt vmcnt(0)" ::: "memory");
        }
    }
    __syncthreads();
}

namespace pg8 {
constexpr int BM = 256, BK = 64, HALF = 128, HTB = HALF * BK * 2  , STAGE_BYTES = 8 * HTB, NXCD = 8, WGM = 8;
__host__ __device__ __forceinline__ int lds_byte(int r, int c) { const int st = (r >> 4) * 2 + (c >> 5), rr = r & 15, cc = c & 31, ob = rr * 64 + cc * 2; return st * 1024 + (ob ^ (((ob >> 9) & 1) << 5)); }
__host__ __device__ __forceinline__ void stage_rc(int b, int& R, int& C) { const int st = b / 1024, sb = b % 1024, swz = sb ^ (((sb >> 9) & 1) << 5); R = (st >> 1) * 16 + swz / 64; C = (st & 1) * 32 + (swz % 64) / 2; }
__host__ __device__ __forceinline__ int perm32(int rho) { const int n = rho >> 4, i = rho & 15; return 8 * (i >> 2) + 4 * n + (i & 3); }

struct Unit { int pm, pn, x0, x1; };
__device__ __forceinline__ void tile_of(int wgid, int nM, int nN, int& pm, int& pn) {
    const int nwg = nM * nN; { const int q = nwg / NXCD, r = nwg % NXCD, xcd = wgid % NXCD, off = wgid / NXCD; wgid = (xcd < r ? xcd * (q + 1) : r * (q + 1) + (xcd - r) * q) + off; }
    const int nig = WGM * nN, gid = wgid / nig, fm = gid * WGM, gsz = (nM - fm) < WGM ? (nM - fm) : WGM;
    pm = fm + ((wgid % nig) % gsz); pn = (wgid % nig) / gsz;
}

template <class Epi, class Sched, bool ALIGN_EPI, bool DUAL = false>
__device__ __forceinline__ void gemm_phase(LAS unsigned char* lds, const int K, const Sched& S, const Epi& E) {
    const int tid = threadIdx.x, wid = __builtin_amdgcn_readfirstlane(tid >> 6), lane = tid & 63, wr = wid >> 2, wc = wid & 3, fr = lane & 15, fq = lane >> 4;
    const int nt = K / BK;
    unsigned voffA[2], voffB[2];
#pragma unroll
    for (int i = 0; i < 2; ++i) { int R, C; stage_rc(tid * 16 + i * 8192, R, C); const int Rb = Epi::PERM ? ((R & ~31) + perm32(R & 31)) : R;
        voffA[i] = (unsigned)(R * (DUAL ? K / 2 : K) + C) * 2u; voffB[i] = (unsigned)(Rb * K + C) * 2u; }
    const size_t kstep = (size_t)(BK * 2);
    const size_t hstep = (size_t)HALF * K * 2;
    const size_t hstepA = (size_t)HALF * (DUAL ? K / 2 : K) * 2;
    const unsigned ldsw = (unsigned)wid * 1024u;
    const int aoff = lds_byte(wr * 64 + fr, fq * 8), boff = lds_byte(wc * 32 + fr, fq * 8);
#define PG8_SA(b, h) (((b) * 2 + (h)) * HTB)
#define PG8_SB(b, h) ((4 + (b) * 2 + (h)) * HTB)
#define PG8_STAGE(bufoff, gbase, voff) do { _Pragma("unroll") for (int _i = 0; _i < 2; ++_i) \
        __builtin_amdgcn_global_load_lds((const unsigned*)((const char*)(gbase) + (voff)[_i]), (LAS unsigned*)(lds + (bufoff) + ldsw + _i * 8192), 16, 0, 0); } while (0)
#define PG8_STAGE_A(bufoff, base, h, NX) do { if constexpr (Sched::GATHER) { _Pragma("unroll") for (int _i = 0; _i < 2; ++_i) { const unsigned _o = (NX) ? gN[h][_i] : gA[h][_i]; \
        __builtin_amdgcn_global_load_lds((const unsigned*)((const char*)(base) + _o), (LAS unsigned*)(lds + (bufoff) + ldsw + _i * 8192), 16, 0, 0); } } \
        else { PG8_STAGE(bufoff, (const char*)(base) + (h) * hstepA, voffA); } } while (0)
#define PG8_LDA(dst, b, h) do { _Pragma("unroll") for (int m = 0; m < 4; ++m) _Pragma("unroll") for (int k = 0; k < 2; ++k) dst[m][k] = *(const LAS bf16x8*)(lds + PG8_SA(b, h) + aoff + m * 2048 + k * 1024); } while (0)
#define PG8_LDB(dst, b, h) do { _Pragma("unroll") for (int n = 0; n < 2; ++n) _Pragma("unroll") for (int k = 0; k < 2; ++k) dst[n][k] = *(const LAS bf16x8*)(lds + PG8_SB(b, h) + boff + n * 2048 + k * 1024); } while (0)
#define PG8_MMA(ai, bj, At, Bt) do { __builtin_amdgcn_s_setprio(1); _Pragma("unroll") for (int m = 0; m < 4; ++m) _Pragma("unroll") for (int n = 0; n < 2; ++n) _Pragma("unroll") for (int k = 0; k < 2; ++k) \
        acc[ai][bj][m][n] = __builtin_amdgcn_mfma_f32_16x16x32_bf16(Bt[n][k], At[m][k], acc[ai][bj][m][n], 0, 0, 0); __builtin_amdgcn_s_setprio(0); } while (0)
#define PG8_WAIT_V(n) asm volatile("s_waitcnt vmcnt(" #n ")" ::: "memory")
#define PG8_WAIT_L(n) asm volatile("s_waitcnt lgkmcnt(" #n ")" ::: "memory")
#define PG8_BAR __builtin_amdgcn_s_barrier()
#define PG8_SCHED __builtin_amdgcn_sched_barrier(0)
#define PG8_AKT(p1, p2, kt) ((DUAL && (kt) >= nt / 2) ? (p2) + (size_t)((kt) - nt / 2) * kstep : (p1) + (size_t)(kt) * kstep)
    Unit cur, nxt; int ui = 0;
    if (!S.next(0, cur)) return;
    f32x4 acc[2][2][4][2];
#pragma unroll
    for (int a = 0; a < 2; ++a)
#pragma unroll
        for (int b = 0; b < 2; ++b)
#pragma unroll
            for (int m = 0; m < 4; ++m)
#pragma unroll
                for (int n = 0; n < 2; ++n) acc[a][b][m][n] = (f32x4){0.f, 0.f, 0.f, 0.f};
    bf16x8 At[4][2], B0[2][2], B1[2][2];
    unsigned gA[2][2] = {{0u, 0u}, {0u, 0u}}, gN[2][2] = {{0u, 0u}, {0u, 0u}};
    const char* cA = S.aptr(cur); const char* cB = S.bptr(cur); const char* cA2 = cA; const char* nA2 = cA;
    if constexpr (DUAL) cA2 = S.aptr2(cur);
    if constexpr (Sched::GATHER) S.aoff(cur, tid, gA);
    PG8_STAGE(PG8_SB(0, 0), cB, voffB); PG8_STAGE(PG8_SB(0, 1), cB + hstep, voffB); PG8_STAGE_A(PG8_SA(0, 0), cA, 0, false); PG8_STAGE_A(PG8_SA(0, 1), cA, 1, false);
    if (wr == 1) PG8_BAR;
    PG8_WAIT_V(2); PG8_BAR;
    PG8_STAGE(PG8_SB(1, 0), cB + kstep, voffB); PG8_STAGE_A(PG8_SA(1, 0), cA + kstep, 0, false); PG8_STAGE(PG8_SB(1, 1), cB + hstep + kstep, voffB);
    PG8_WAIT_V(6); PG8_BAR;
    for (;;) {
        const bool has_next = S.next(ui + 1, nxt);
        const char* nA = has_next ? S.aptr(nxt) : cA; const char* nB = has_next ? S.bptr(nxt) : cB;
        if constexpr (DUAL) nA2 = has_next ? S.aptr2(nxt) : cA2;
        if constexpr (Sched::GATHER) { if (has_next) S.aoff(nxt, tid, gN); else {
#pragma unroll
            for (int h = 0; h < 2; ++h) { gN[h][0] = gA[h][0]; gN[h][1] = gA[h][1]; } } }
        for (int t = 0; t < nt; t += 2) {
            const bool last = (t == nt - 2);
            const char* a1 = PG8_AKT(cA, cA2, t + 1);
            const char* a2 = last ? nA : PG8_AKT(cA, cA2, t + 2); const char* b2 = last ? nB : cB + (size_t)(t + 2) * kstep;
            const char* a3 = last ? nA + kstep : PG8_AKT(cA, cA2, t + 3); const char* b3 = b2 + kstep;
            if constexpr (DUAL) { if (t == nt / 2) E.mid(acc, cur, wr, wc, fr, fq); }
            PG8_LDB(B0, 0, 0); PG8_LDB(B1, 0, 1); PG8_SCHED; PG8_LDA(At, 0, 0); PG8_STAGE_A(PG8_SA(1, 1), a1, 1, false);
            PG8_WAIT_V(8); PG8_WAIT_L(0); PG8_BAR; PG8_MMA(0, 0, At, B0); PG8_MMA(0, 1, At, B1); PG8_BAR; PG8_SCHED;
            PG8_LDA(At, 0, 1); PG8_STAGE(PG8_SB(0, 0), b2, voffB); PG8_STAGE(PG8_SB(0, 1), b2 + hstep, voffB); PG8_STAGE_A(PG8_SA(0, 0), a2, 0, last);
            PG8_WAIT_V(8); PG8_WAIT_L(0); PG8_BAR; PG8_MMA(1, 0, At, B0); PG8_MMA(1, 1, At, B1); PG8_BAR; PG8_SCHED;
            PG8_LDB(B0, 1, 0); PG8_LDB(B1, 1, 1); PG8_SCHED; PG8_LDA(At, 1, 0); PG8_STAGE_A(PG8_SA(0, 1), a2, 1, last);
            PG8_WAIT_V(8); PG8_WAIT_L(0); PG8_BAR; PG8_MMA(0, 0, At, B0); PG8_MMA(0, 1, At, B1); PG8_BAR; PG8_SCHED;
            PG8_LDA(At, 1, 1); PG8_STAGE(PG8_SB(1, 0), b3, voffB); PG8_STAGE(PG8_SB(1, 1), b3 + hstep, voffB); PG8_STAGE_A(PG8_SA(1, 0), a3, 0, last);
            PG8_WAIT_V(8); PG8_WAIT_L(0); PG8_BAR; PG8_MMA(1, 0, At, B0); PG8_MMA(1, 1, At, B1); PG8_BAR; PG8_SCHED;
        }
        if constexpr (ALIGN_EPI) { if (wr == 0) PG8_BAR; }
        E(acc, cur, wr, wc, fr, fq);
        if (!has_next) break;
#pragma unroll
        for (int a = 0; a < 2; ++a)
#pragma unroll
            for (int b = 0; b < 2; ++b)
#pragma unroll
                for (int m = 0; m < 4; ++m)
#pragma unroll
                    for (int n = 0; n < 2; ++n) acc[a][b][m][n] = (f32x4){0.f, 0.f, 0.f, 0.f};
        cur = nxt; cA = nA; cB = nB; ++ui; if constexpr (DUAL) cA2 = nA2;
        if constexpr (Sched::GATHER) {
#pragma unroll
            for (int h = 0; h < 2; ++h) { gA[h][0] = gN[h][0]; gA[h][1] = gN[h][1]; } }
        if constexpr (ALIGN_EPI) { if (wr == 1) PG8_BAR; }
    }
    PG8_WAIT_V(0);
    if constexpr (!ALIGN_EPI) { if (wr == 0) PG8_BAR; }
    PG8_BAR;
#undef PG8_AKT
#undef PG8_SA
#undef PG8_SB
#undef PG8_STAGE
#undef PG8_STAGE_A
#undef PG8_LDA
#undef PG8_LDB
#undef PG8_MMA
#undef PG8_WAIT_V
#undef PG8_WAIT_L
#undef PG8_BAR
#undef PG8_SCHED
}
}

struct Frame {
    LAS unsigned char* lds;
    gu32* ctl;
    int tid, lane, wave, G, vcu;
    const float* in[23]; float* out; unsigned char* ws;
};
#define IN_X 0
#define IN_C 1
#define IN_CTX 2
#define IN_CCTX 3
#define IN_WADA 4
#define IN_BADA 5
#define IN_N1W 6
#define IN_WIN 7
#define IN_BMG 8
#define IN_QNW 9
#define IN_KNW 10
#define IN_MHW 11
#define IN_WBM 12
#define IN_WBA 13
#define IN_WOUT 14
#define IN_N2W 15
#define IN_WRG 16
#define IN_BRG 17
#define IN_WRE 18
#define IN_BRE 19
#define IN_WEG 20
#define IN_WEU 21
#define IN_WED 22

__device__ __forceinline__ void p0_ada(Frame& F) {
    LAS float* sl = (LAS float*)F.lds;
    LAS float* red = sl + 17 * 1024;
    const float* cc = F.in[IN_C]; const float* cx = F.in[IN_CCTX];
    for (int i = F.tid; i < 17 * 1024; i += NTHREADS) { const int r = i >> 10, k = i & 1023; const float c = r < 16 ? cc[r * 1024 + k] : cx[k]; sl[i] = siluf_(c); }
    __syncthreads();
    const float* W = F.in[IN_WADA]; const float* bias = F.in[IN_BADA]; float* mod = (float*)(F.ws + WS_MOD);
    const int j = F.lane & 31, kk = F.lane >> 5;
    for (int cb = blockIdx.x; cb < 256; cb += F.G) {
        const int col0 = cb * 24;
        float acc[17];
#pragma unroll
        for (int r = 0; r < 17; ++r) acc[r] = 0.f;
        if (j < 24) {
#pragma unroll 4
            for (int it = 0; it < 64; ++it) { const int k = F.wave * 128 + it * 2 + kk; const float w = W[(size_t)k * NMOD + col0 + j];
#pragma unroll
                for (int r = 0; r < 17; ++r) acc[r] += sl[r * 1024 + k] * w; }
        }
#pragma unroll
        for (int r = 0; r < 17; ++r) acc[r] += __shfl_xor(acc[r], 32);
        if (F.lane < 32) {
#pragma unroll
            for (int r = 0; r < 17; ++r) red[(F.wave * 17 + r) * 32 + j] = acc[r]; }
        __syncthreads();
        if (F.tid < 17 * 24) { const int r = F.tid / 24, jj = F.tid % 24; float s = 0.f;
#pragma unroll
            for (int w = 0; w < 8; ++w) s += red[(w * 17 + r) * 32 + jj];
            mod[r * NMOD + col0 + jj] = s + bias[col0 + jj]; }
        __syncthreads();
    }
}
template <class DR>
__device__ __forceinline__ void transpose_item(const float* W, int K, int N, bf16_t* WT, const DR& destrow, LAS float* scr, int item, int lane, int ldw = 0, int koff = 0) {
    if (ldw == 0) ldw = K;
    const int nblk = N / 32, kb = item / nblk, nb = item % nblk, k0 = 64 * kb, n0 = 32 * nb;
#pragma unroll 8
    for (int i = 0; i < 32; ++i) { const int kk = 2 * i + (lane >> 5); scr[kk * 33 + (lane & 31)] = W[(size_t)(k0 + kk) * N + n0 + (lane & 31)]; }
    LDS_WAIT(); asm volatile("" ::: "memory");
    const int c = lane & 7;
#pragma unroll
    for (int j = 0; j < 4; ++j) { const int n = (lane >> 3) + 8 * j; const LAS float* s = scr + (8 * c) * 33 + n;
        u32x4 o; o.x = pk2(s[0 * 33], s[1 * 33]); o.y = pk2(s[2 * 33], s[3 * 33]); o.z = pk2(s[4 * 33], s[5 * 33]); o.w = pk2(s[6 * 33], s[7 * 33]);
        *(GAS u32x4*)(WT + (size_t)destrow(n0 + n) * ldw + koff + k0 + 8 * c) = o; }
    LDS_WAIT(); asm volatile("" ::: "memory");
}
struct DrIdent { int off; __device__ __forceinline__ int operator()(int n) const { return off + n; } };
__device__ __forceinline__ int qk_pos(int d) { const int half = d >> 6, dl = d & 63, n = dl >> 5, i = dl & 31; return 32 * (2 * half + (i >> 4)) + 8 * ((i >> 2) & 3) + 4 * n + (i & 3); }
struct DrWin { __device__ __forceinline__ int operator()(int n) const {
    if (n < 1024) return 2816 + n;
    if (n < 2048) return n - 1024;
    if (n < 3072) return 1024 + (n - 2048);
    if (n < 4096) return 3840 + (n - 3072);
    if (n < 4128) return 2560 + (n - 4096);
    if (n < 5152) { const int q = n - 4128; return 4864 + (q & ~127) + qk_pos(q & 127); }
    if (n < 5408) { const int q = n - 5152; return 2048 + (q & ~127) + qk_pos(q & 127); }
    if (n < 5664) return 2304 + (n - 5408);
    return 5888 + (n - 5664); } };
__device__ __forceinline__ void p0_prologue(Frame& F) {
    p0_ada(F);
    __syncthreads();
    LAS float* scr = (LAS float*)(F.lds + F.wave * 16384);
    const int gw = F.vcu * NWAVES + F.wave, NGW = F.G * NWAVES;
    constexpr int I_IN = 16 * (IN_W / 32), I_SQ = 16 * 32;
    bf16_t* win_t = (bf16_t*)(F.ws + WS_WIN);
    for (int it = gw; it < I_IN + 3 * I_SQ; it += NGW) {
        int r = it;
        if (r < I_IN) { transpose_item(F.in[IN_WIN], D, IN_W, win_t, DrWin{}, scr, r, F.lane); continue; } r -= I_IN;
        if (r < I_SQ) { transpose_item(F.in[IN_WBM], D, D, (bf16_t*)(F.ws + WS_WBM), DrIdent{0}, scr, r, F.lane, 2 * D, 0); continue; } r -= I_SQ;
        if (r < I_SQ) { transpose_item(F.in[IN_WBA], D, D, (bf16_t*)(F.ws + WS_WBM), DrIdent{0}, scr, r, F.lane, 2 * D, D); continue; } r -= I_SQ;
        transpose_item(F.in[IN_WOUT], D, D, (bf16_t*)(F.ws + WS_WO), DrIdent{0}, scr, r, F.lane);
    }
    { GAS u32x4* z = (GAS u32x4*)(win_t + (size_t)2592 * D); const int n16 = 224 * D * 2 / 16;
      for (int i = blockIdx.x * NTHREADS + F.tid; i < n16; i += F.G * NTHREADS) z[i] = (u32x4){0u, 0u, 0u, 0u}; }
    { bf16_t* wr = (bf16_t*)(F.ws + WS_WR); const float* wrg = F.in[IN_WRG]; const float* wre = F.in[IN_WRE];
      for (int i = blockIdx.x * NTHREADS + F.tid; i < 256 * D; i += F.G * NTHREADS) { const int o = i >> 10, k = i & 1023; const int oo = o < 36 ? o : ((o >= 64 && o < 100) ? o - 64 : -1);
          unsigned v = 0u; if (oo >= 0) { const float w = oo < 4 ? wrg[k * 4 + oo] : wre[k * 32 + oo - 4]; const unsigned hi = f2bf(w); v = o < 36 ? hi : f2bf(w - __builtin_bit_cast(float, hi << 16)); }
          wr[i] = (bf16_t)v; } }
    { float* tab = (float*)(F.ws + WS_ROPE);
      for (int i = blockIdx.x * NTHREADS + F.tid; i < 2048; i += F.G * NTHREADS) { const int pos = i >> 5, fi = i & 31;
          const float inv = powf(10000.0f, -(float)(2 * fi) / 64.0f); const float ang = (float)pos * inv; tab[i] = cosf(ang); tab[2048 + i] = sinf(ang); } }
}

__device__ __forceinline__ void p1_a0(Frame& F) {
    const int gw = F.vcu * NWAVES + F.wave, NGW = F.G * NWAVES;
    const float* mod = (const float*)(F.ws + WS_MOD); const float* n1w = F.in[IN_N1W]; bf16_t* A0 = (bf16_t*)(F.ws + WS_A0);
    for (int row = gw; row < T_ALL; row += NGW) {
        const float* src = row < T_LAT ? F.in[IN_X] + (size_t)row * D : F.in[IN_CTX] + (size_t)(row - T_LAT) * D;
        const int mr = row < T_LAT ? row / SEQ : 16;
        const GAS f32x4* xr = (const GAS f32x4*)src + F.lane;
        f32x4 v[4]; float s = 0.f;
#pragma unroll
        for (int j = 0; j < 4; ++j) { v[j] = xr[64 * j]; s += (v[j].x * v[j].x + v[j].y * v[j].y) + (v[j].z * v[j].z + v[j].w * v[j].w); }
        const float rinv = 1.0f / sqrtf(wave_sum(s) * (1.0f / D) + EPS);
        GAS u32x2* o8 = (GAS u32x2*)(A0 + (size_t)row * D) + F.lane;
#pragma unroll
        for (int j = 0; j < 4; ++j) { const int col = 256 * j + 4 * F.lane;
            const f32x4 w = *(const f32x4*)(n1w + col), sh = *(const f32x4*)(mod + mr * NMOD + col), sc = *(const f32x4*)(mod + mr * NMOD + D + col);
            const f32x4 y = (v[j] * rinv) * w * (sc + 1.0f) + sh;
            u32x2 o; o.x = pk2(y.x, y.y); o.y = pk2(y.z, y.w); o8[64 * j] = o; }
    }
}

struct InProjOrder { static constexpr bool GATHER = false; const char* A; const char* Bt; int G, c;
    __device__ __forceinline__ bool next(int i, pg8::Unit& u) const { const long L = (long)i * G + c; constexpr int NL = MT_LAT * NT_LAT, NC = MT_CTX * NT_CTX; if (L >= NL + NC) return false;
        if (L < NL) pg8::tile_of((int)L, MT_LAT, NT_LAT, u.pm, u.pn); else { const int q = (int)L - NL; u.pm = MT_LAT + q % MT_CTX; u.pn = q / MT_CTX; } u.x0 = 0; u.x1 = 0; return true; }
    __device__ __forceinline__ const char* aptr(const pg8::Unit& u) const { return A + (size_t)u.pm * (256 * D * 2); }
    __device__ __forceinline__ const char* bptr(const pg8::Unit& u) const { return Bt + (size_t)u.pn * (256 * D * 2); }
    __device__ __forceinline__ void aoff(const pg8::Unit&, int, unsigned (&)[2][2]) const {}
};
__device__ __forceinline__ int krow_of(int r0) { if (r0 < T_LAT) return (r0 / SEQ) * KVL + (r0 % SEQ); const int q = r0 - T_LAT; return (q / CTXL) * KVL + SEQ + (q % CTXL); }
struct EpiInProj { static constexpr bool PERM = true; unsigned char* ws; bf16_t* mg; const float* bgate; const float* qnw; const float* knw; LAS unsigned char* lds;
    __device__ __forceinline__ void operator()(const f32x4 (&acc)[2][2][4][2], const pg8::Unit& u, int wr, int wc, int fr, int fq) const {
        const int pn = u.pn; int r0 = u.pm * 256; bf16_t* base; int ldc = D, colt;
        if (pn == 10) {
            if (wc == 0) { float* g = (float*)(ws + WS_GATES); const f32x4 b0 = *(const f32x4*)(bgate + 8 * fq), b1 = *(const f32x4*)(bgate + 8 * fq + 4);
#pragma unroll
                for (int ai = 0; ai < 2; ++ai)
#pragma unroll
                    for (int m = 0; m < 4; ++m) { float* p = g + (size_t)(r0 + ai * 128 + wr * 64 + m * 16 + fr) * 32 + 8 * fq;
                        *(f32x4*)p = acc[ai][0][m][0] + b0; *(f32x4*)(p + 4) = acc[ai][0][m][1] + b1; } }
            return; }
        const bool isk = pn == 8, isq = pn >= 19 && pn < 23;
        const int t0 = u.pm < MT_LAT ? (r0 % SEQ) : -1;
        if (pn < 4) { base = (bf16_t*)(ws + WS_MK); colt = pn * 256; }
        else if (pn < 8) { base = (bf16_t*)(ws + WS_MV); colt = (pn - 4) * 256; }
        else if (pn < 10) { base = (bf16_t*)(ws + (pn == 8 ? WS_AK : WS_AV)); ldc = 256; colt = 0; r0 = krow_of(r0); }
        else if (pn < 15) { base = (bf16_t*)(ws + WS_MQ); colt = (pn - 11) * 256; }
        else if (pn < 19) { base = (bf16_t*)(ws + WS_OG); colt = (pn - 15) * 256; }
        else if (pn < 23) { base = (bf16_t*)(ws + WS_AQ); colt = (pn - 19) * 256; }
        else { base = mg; ldc = 2 * D; colt = (pn - 23) * 256; }
        const int row0 = r0 + wr * 64 + fr, col0 = colt + wc * 32 + 8 * fq;
        if (isk || isq) {
            LAS float* xs = (LAS float*)(lds + pg8::STAGE_BYTES);
#pragma unroll
            for (int ai = 0; ai < 2; ++ai)
#pragma unroll
                for (int m = 0; m < 4; ++m)
#pragma unroll
                    for (int bj = 0; bj < 2; ++bj) { const f32x4 a = acc[ai][bj][m][0], b = acc[ai][bj][m][1];
                        float ss = (a[0] * a[0] + a[1] * a[1]) + (a[2] * a[2] + a[3] * a[3]) + (b[0] * b[0] + b[1] * b[1]) + (b[2] * b[2] + b[3] * b[3]);
                        ss += __shfl_xor(ss, 16); ss += __shfl_xor(ss, 32);
                        if (fq == 0) xs[(bj * 256 + ai * 128 + wr * 64 + m * 16 + fr) * 4 + wc] = ss; }
            LDS_WAIT(); __builtin_amdgcn_s_barrier(); asm volatile("" ::: "memory");
            const float* nw = isk ? knw : qnw; const float* tab = (const float*)(ws + WS_ROPE);
            const int dlo = 64 * (wc >> 1) + 16 * (wc & 1) + 4 * fq;
            const f32x4 w0 = *(const f32x4*)(nw + dlo), w1 = *(const f32x4*)(nw + dlo + 32);
#pragma unroll
            for (int ai = 0; ai < 2; ++ai)
#pragma unroll
                for (int m = 0; m < 4; ++m) { const int rl = ai * 128 + wr * 64 + m * 16 + fr; bf16_t* rowp = base + (size_t)(row0 + ai * 128 + m * 16) * ldc + col0;
                    f32x4 cs = (f32x4){1.f, 1.f, 1.f, 1.f}, sn = (f32x4){0.f, 0.f, 0.f, 0.f};
                    if (t0 >= 0) { const int t = t0 + rl; const int pos = (wc >> 1) ? (t & 63) : (t >> 6); cs = *(const f32x4*)(tab + pos * 32 + 16 * (wc & 1) + 4 * fq); sn = *(const f32x4*)(tab + 2048 + pos * 32 + 16 * (wc & 1) + 4 * fq); }
#pragma unroll
                    for (int bj = 0; bj < 2; ++bj) { const f32x4 p4 = *(const LAS f32x4*)(xs + (bj * 256 + rl) * 4);
                        const float rinv = 1.0f / sqrtf(((p4.x + p4.y) + (p4.z + p4.w)) * (1.0f / 128.0f) + EPS);
                        const f32x4 x1 = (acc[ai][bj][m][0] * rinv) * w0, x2 = (acc[ai][bj][m][1] * rinv) * w1;
                        const f32x4 y1 = x1 * cs - x2 * sn, y2 = x2 * cs + x1 * sn;
                        u32x4 w; w.x = cvt_pk_bf16(y1[0], y1[1]); w.y = cvt_pk_bf16(y1[2], y1[3]); w.z = cvt_pk_bf16(y2[0], y2[1]); w.w = cvt_pk_bf16(y2[2], y2[3]);
                        *(u32x4*)(rowp + bj * 128) = w; } }
            return; }
#pragma unroll
        for (int ai = 0; ai < 2; ++ai)
#pragma unroll
            for (int m = 0; m < 4; ++m) { bf16_t* rowp = base + (size_t)(row0 + ai * 128 + m * 16) * ldc + col0;
#pragma unroll
                for (int bj = 0; bj < 2; ++bj) { const f32x4 v0 = acc[ai][bj][m][0], v1 = acc[ai][bj][m][1];
                    u32x4 w; w.x = cvt_pk_bf16(v0[0], v0[1]); w.y = cvt_pk_bf16(v0[2], v0[3]); w.z = cvt_pk_bf16(v1[0], v1[1]); w.w = cvt_pk_bf16(v1[2], v1[3]);
                    *(u32x4*)(rowp + bj * 128) = w; } }
    }
};


namespace ml {
constexpr int PQ = 272, PT = 144, PH = 528;
constexpr int QS = 0, KS = 64 * PQ, HST = 0;
constexpr int KT = 2 * 64 * PQ;
constexpr int VT = KT + 128 * PT;
constexpr int CT = VT + 128 * PT;
constexpr int PP = CT + 128 * PQ;
constexpr int SC = PP + 64 * PT;
constexpr int S_A = 0, S_M = 64, S_WI = 128, S_EQ = 192, S_WIN = 256, S_RS0 = 320, S_RS1 = 384, S_QN = 448, S_N = 512, S_WOLD = 640;
constexpr int END = SC + 4096;
static_assert(64 * PH <= 2 * 64 * PQ, "h staging fits over q|k");
constexpr float QSCALE = 0.08838834764831845f;

__device__ __forceinline__ bf16x8 frag(const LAS unsigned char* base, int pitch, int tile, int ks, int lane) {
    return *(const LAS bf16x8*)(base + (16 * tile + (lane & 15)) * pitch + (32 * ks + 8 * (lane >> 4)) * 2);
}
__device__ __forceinline__ float logsig(float x) { return fminf(x, 0.f) - log1pf(expf(-fabsf(x))); }

__device__ __forceinline__ void unit(Frame& F, int b, int h) {
    LAS unsigned char* L = F.lds; LAS float* sc = (LAS float*)(L + SC);
    const int tid = F.tid, lane = F.lane, w = F.wave;
    const bf16_t* MQ = (const bf16_t*)(F.ws + WS_MQ); const bf16_t* MK = (const bf16_t*)(F.ws + WS_MK); const bf16_t* MV = (const bf16_t*)(F.ws + WS_MV);
    const bf16_t* OG = (const bf16_t*)(F.ws + WS_OG); bf16_t* HT = (bf16_t*)(F.ws + WS_HTMP); bf16_t* AM = (bf16_t*)(F.ws + WS_MQ);
    const float* GT = (const float*)(F.ws + WS_GATES); const float* mhw = F.in[IN_MHW];
    const int lr = tid >> 3, seg = tid & 7;
    for (int dir = 0; dir < 2; ++dir) {
        f32x4 accC[8];
#pragma unroll
        for (int e = 0; e < 8; ++e) accC[e] = (f32x4){0.f, 0.f, 0.f, 0.f};
        for (int i = tid; i < 128 * PQ / 4; i += NTHREADS) ((LAS unsigned*)(L + CT))[i] = 0u;
        if (tid < 128) sc[S_N + tid] = 0.f;
        float m_run = -1e30f;
        u32x4 rq0, rq1, rk0, rk1, rv0, rv1; float g_i = 0.f, g_f = 0.f;
        rq0 = rq1 = rk0 = rk1 = rv0 = rv1 = (u32x4){0u, 0u, 0u, 0u};
#define ML_GROW(st, r) ((st) < 4 ? (T_LAT + b * CTXL + (dir == 0 ? (st) * 64 + (r) : (3 - (st)) * 64 + 63 - (r))) : (b * SEQ + (dir == 0 ? ((st) - 4) * 64 + (r) : (35 - (st)) * 64 + 63 - (r))))
#define ML_LOAD(st) do { const size_t go = (size_t)ML_GROW(st, lr) * D + h * 128 + seg * 16; \
            if ((st) >= 4) { rq0 = *(const GAS u32x4*)(MQ + go); rq1 = *(const GAS u32x4*)(MQ + go + 8); } \
            rk0 = *(const GAS u32x4*)(MK + go); rk1 = *(const GAS u32x4*)(MK + go + 8); rv0 = *(const GAS u32x4*)(MV + go); rv1 = *(const GAS u32x4*)(MV + go + 8); \
            if (w == 0) { const float* gp = GT + (size_t)ML_GROW(st, lane) * 32 + dir * 16 + h; g_i = gp[0]; g_f = gp[8]; } } while (0)
        ML_LOAD(0);
        for (int st = 0; st < 36; ++st) {
            const bool lat = st >= 4;
            if (w == 0) {
                const float lf = logsig(g_f);
                float bc = lf;
#pragma unroll
                for (int o = 1; o < 64; o <<= 1) { const float t = __shfl_up(bc, o); if (lane >= o) bc += t; }
                const float a = g_i - bc;
                float pm = a;
#pragma unroll
                for (int o = 1; o < 64; o <<= 1) { const float t = __shfl_up(pm, o); if (lane >= o) pm = fmaxf(pm, t); }
                const float M = fmaxf(m_run, pm);
                const float blast = __shfl(bc, 63);
                const float dec = blast - bc + g_i;
                const float mnew = fmaxf(blast + m_run, wave_max(dec));
                sc[S_A + lane] = a; sc[S_M + lane] = M; sc[S_WI + lane] = expf(m_run - M); sc[S_EQ + lane] = expf(-(bc + M)); sc[S_WIN + lane] = expf(dec - mnew);
                if (lane == 0) sc[S_WOLD] = expf(blast + m_run - mnew);
                m_run = mnew;
            }
            LDS_WAIT(); __syncthreads();
            {
                const float win = sc[S_WIN + lr];
                if (lat) { *(LAS u32x4*)(L + QS + lr * PQ + seg * 32) = rq0; *(LAS u32x4*)(L + QS + lr * PQ + seg * 32 + 16) = rq1;
                           *(LAS u32x4*)(L + KS + lr * PQ + seg * 32) = rk0; *(LAS u32x4*)(L + KS + lr * PQ + seg * 32 + 16) = rk1; }
                const unsigned kw[8] = {rk0.x, rk0.y, rk0.z, rk0.w, rk1.x, rk1.y, rk1.z, rk1.w};
                const unsigned vw[8] = {rv0.x, rv0.y, rv0.z, rv0.w, rv1.x, rv1.y, rv1.z, rv1.w};
#pragma unroll
                for (int j = 0; j < 8; ++j) {
                    LAS unsigned short* kt = (LAS unsigned short*)(L + KT + (seg * 16 + 2 * j) * PT + lr * 2);
                    kt[0] = (unsigned short)f2bf(bflo(kw[j]) * win); kt[PT / 2] = (unsigned short)f2bf(bfhi(kw[j]) * win);
                    LAS unsigned short* vt = (LAS unsigned short*)(L + VT + (seg * 16 + 2 * j) * PT + lr * 2);
                    vt[0] = (unsigned short)(vw[j] & 0xffffu); vt[PT / 2] = (unsigned short)(vw[j] >> 16);
                }
            }
            if (st + 1 < 36) ML_LOAD(st + 1);
            LDS_WAIT(); __syncthreads();
            f32x4 acch[4];
            const int si = w >> 1, eb = 4 * (w & 1);
            if (lat) {
                bf16x8 qf[4];
#pragma unroll
                for (int ks = 0; ks < 4; ++ks) qf[ks] = frag(L + QS, PQ, si, ks, lane);
                const int s_col = 16 * si + (lane & 15); const float Ms = sc[S_M + s_col];
                float psum = 0.f;
#pragma unroll
                for (int rr = 0; rr < 2; ++rr) { const int ri = 2 * (w & 1) + rr; f32x4 a4 = (f32x4){0.f, 0.f, 0.f, 0.f};
#pragma unroll
                    for (int ks = 0; ks < 4; ++ks) a4 = __builtin_amdgcn_mfma_f32_16x16x32_bf16(frag(L + KS, PQ, ri, ks, lane), qf[ks], a4, 0, 0, 0);
                    const int r0 = 16 * ri + 4 * (lane >> 4); float p[4];
#pragma unroll
                    for (int j = 0; j < 4; ++j) { const int r = r0 + j; p[j] = (r <= s_col) ? a4[j] * QSCALE * __expf(sc[S_A + r] - Ms) : 0.f; psum += p[j]; }
                    u32x2 pw; pw.x = pk2(p[0], p[1]); pw.y = pk2(p[2], p[3]);
                    *(LAS u32x2*)(L + PP + s_col * PT + r0 * 2) = pw; }
                psum += __shfl_xor(psum, 16); psum += __shfl_xor(psum, 32);
                if (lane < 16) sc[((w & 1) ? S_RS1 : S_RS0) + s_col] = psum;
                { const u32x4 q0 = *(const LAS u32x4*)(L + QS + lr * PQ + seg * 32), q1 = *(const LAS u32x4*)(L + QS + lr * PQ + seg * 32 + 16);
                  const LAS float* nv = sc + S_N + seg * 16;
                  float d = bflo(q0.x) * nv[0] + bfhi(q0.x) * nv[1] + bflo(q0.y) * nv[2] + bfhi(q0.y) * nv[3] + bflo(q0.z) * nv[4] + bfhi(q0.z) * nv[5] + bflo(q0.w) * nv[6] + bfhi(q0.w) * nv[7]
                          + bflo(q1.x) * nv[8] + bfhi(q1.x) * nv[9] + bflo(q1.y) * nv[10] + bfhi(q1.y) * nv[11] + bflo(q1.z) * nv[12] + bfhi(q1.z) * nv[13] + bflo(q1.w) * nv[14] + bfhi(q1.w) * nv[15];
                  d += __shfl_xor(d, 1); d += __shfl_xor(d, 2); d += __shfl_xor(d, 4);
                  if (seg == 0) sc[S_QN + lr] = d; }
#pragma unroll
                for (int e = 0; e < 4; ++e) { acch[e] = (f32x4){0.f, 0.f, 0.f, 0.f};
#pragma unroll
                    for (int ks = 0; ks < 4; ++ks) acch[e] = __builtin_amdgcn_mfma_f32_16x16x32_bf16(qf[ks], frag(L + CT, PQ, eb + e, ks, lane), acch[e], 0, 0, 0); }
            }
            LDS_WAIT(); __syncthreads();
            {
                const float wold = sc[S_WOLD];
                const bf16x8 ka0 = frag(L + KT, PT, w, 0, lane), ka1 = frag(L + KT, PT, w, 1, lane);
#pragma unroll
                for (int e = 0; e < 8; ++e) { accC[e] = accC[e] * wold;
                    accC[e] = __builtin_amdgcn_mfma_f32_16x16x32_bf16(ka0, frag(L + VT, PT, e, 0, lane), accC[e], 0, 0, 0);
                    accC[e] = __builtin_amdgcn_mfma_f32_16x16x32_bf16(ka1, frag(L + VT, PT, e, 1, lane), accC[e], 0, 0, 0);
                    u32x2 cw; cw.x = pk2(accC[e][0], accC[e][1]); cw.y = pk2(accC[e][2], accC[e][3]);
                    *(LAS u32x2*)(L + CT + (16 * e + (lane & 15)) * PQ + (16 * w + 4 * (lane >> 4)) * 2) = cw; }
                { const int d = tid >> 2, rq = tid & 3; const u32x4 k0 = *(const LAS u32x4*)(L + KT + d * PT + rq * 32), k1 = *(const LAS u32x4*)(L + KT + d * PT + rq * 32 + 16);
                  float s = bflo(k0.x) + bfhi(k0.x) + bflo(k0.y) + bfhi(k0.y) + bflo(k0.z) + bfhi(k0.z) + bflo(k0.w) + bfhi(k0.w)
                          + bflo(k1.x) + bfhi(k1.x) + bflo(k1.y) + bfhi(k1.y) + bflo(k1.z) + bfhi(k1.z) + bflo(k1.w) + bfhi(k1.w);
                  s += __shfl_xor(s, 1); s += __shfl_xor(s, 2);
                  if (rq == 0) sc[S_N + d] = wold * sc[S_N + d] + s; }
            }
            if (lat) {
                const int s0 = 16 * si + 4 * (lane >> 4);
                float rwi[4], rden[4];
#pragma unroll
                for (int j = 0; j < 4; ++j) { const int s = s0 + j; rwi[j] = QSCALE * sc[S_WI + s]; const float den = rwi[j] * sc[S_QN + s] + sc[S_RS0 + s] + sc[S_RS1 + s]; rden[j] = 1.0f / fmaxf(fabsf(den), sc[S_EQ + s]); }
                const bf16x8 pf0 = frag(L + PP, PT, si, 0, lane), pf1 = frag(L + PP, PT, si, 1, lane);
#pragma unroll
                for (int e = 0; e < 4; ++e) {
#pragma unroll
                    for (int j = 0; j < 4; ++j) acch[e][j] *= rwi[j];
                    acch[e] = __builtin_amdgcn_mfma_f32_16x16x32_bf16(pf0, frag(L + VT, PT, eb + e, 0, lane), acch[e], 0, 0, 0);
                    acch[e] = __builtin_amdgcn_mfma_f32_16x16x32_bf16(pf1, frag(L + VT, PT, eb + e, 1, lane), acch[e], 0, 0, 0);
#pragma unroll
                    for (int j = 0; j < 4; ++j) *(LAS float*)(L + HST + (s0 + j) * PH + (16 * (eb + e) + (lane & 15)) * 4) = acch[e][j] * rden[j]; }
            }
            LDS_WAIT(); __syncthreads();
            if (lat) {
                const LAS f32x4* hp = (const LAS f32x4*)(L + HST + lr * PH + seg * 64);
                f32x4 hv[4];
#pragma unroll
                for (int j = 0; j < 4; ++j) hv[j] = hp[j];
                const size_t go = (size_t)ML_GROW(st, lr) * D + h * 128 + seg * 16;
                if (dir == 0) {
                    u32x4 o0, o1; o0.x = pk2(hv[0].x, hv[0].y); o0.y = pk2(hv[0].z, hv[0].w); o0.z = pk2(hv[1].x, hv[1].y); o0.w = pk2(hv[1].z, hv[1].w);
                    o1.x = pk2(hv[2].x, hv[2].y); o1.y = pk2(hv[2].z, hv[2].w); o1.z = pk2(hv[3].x, hv[3].y); o1.w = pk2(hv[3].z, hv[3].w);
                    *(GAS u32x4*)(HT + go) = o0; *(GAS u32x4*)(HT + go + 8) = o1;
                } else {
                    const u32x4 f0 = *(const GAS u32x4*)(HT + go), f1 = *(const GAS u32x4*)(HT + go + 8), g0 = *(const GAS u32x4*)(OG + go), g1 = *(const GAS u32x4*)(OG + go + 8);
                    const unsigned fw[8] = {f0.x, f0.y, f0.z, f0.w, f1.x, f1.y, f1.z, f1.w}, gw[8] = {g0.x, g0.y, g0.z, g0.w, g1.x, g1.y, g1.z, g1.w};
                    float x[16]; float ss = 0.f;
#pragma unroll
                    for (int j = 0; j < 8; ++j) { x[2 * j] = hv[j >> 1][(2 * j) & 3] + bflo(fw[j]); x[2 * j + 1] = hv[j >> 1][(2 * j + 1) & 3] + bfhi(fw[j]); ss += x[2 * j] * x[2 * j] + x[2 * j + 1] * x[2 * j + 1]; }
                    ss += __shfl_xor(ss, 1); ss += __shfl_xor(ss, 2); ss += __shfl_xor(ss, 4);
                    const float rinv = 1.0f / sqrtf(ss * (1.0f / 128.0f) + EPS);
                    const float* mw = mhw + h * 128 + seg * 16; unsigned ow[8];
#pragma unroll
                    for (int j = 0; j < 8; ++j) { const float y0 = (x[2 * j] * rinv) * mw[2 * j] * sigmoidf_(bflo(gw[j])), y1 = (x[2 * j + 1] * rinv) * mw[2 * j + 1] * sigmoidf_(bfhi(gw[j])); ow[j] = pk2(y0, y1); }
                    *(GAS u32x4*)(AM + go) = (u32x4){ow[0], ow[1], ow[2], ow[3]}; *(GAS u32x4*)(AM + go + 8) = (u32x4){ow[4], ow[5], ow[6], ow[7]};
                }
            }
        }
        VM_WAIT(); __syncthreads();
#undef ML_LOAD
#undef ML_GROW
    }
}
}

namespace at {
constexpr int QBLK = 32, KVBLK = 64, LDQ = D, LDK = 256, LDO = D;
constexpr float SCALE = 0.088388347648318440f;
constexpr float THR = 8.f;
constexpr size_t SHM_V = KVBLK * 128 * 2, SHM_K = KVBLK * 128 * 2, SHM_ATTN = 2 * SHM_V + 2 * SHM_K + NWAVES * 64 * 4;
#define KSWZ(row, colB) ((row) * 256 + ((colB) ^ (((row) & 7) << 4)))
#define SBAR() __builtin_amdgcn_sched_barrier(0)
__device__ __forceinline__ int crow(int r, int hi) { return (r & 3) + 8 * (r >> 2) + 4 * hi; }
__device__ __forceinline__ void partialSM(f32x16& p0, f32x16& p1, float& m_reg, float& mn, float& alpha) {
  constexpr float C = SCALE * 1.4426950408889634f;
  float pmax = p0[0];
#pragma unroll
  for (int r = 1; r < 16; ++r) pmax = fmaxf(pmax, p0[r]);
#pragma unroll
  for (int r = 0; r < 16; ++r) pmax = fmaxf(pmax, p1[r]);
  { auto rr = __builtin_amdgcn_permlane32_swap(__float_as_uint(pmax), __float_as_uint(pmax), false, false);
    pmax = fmaxf(__uint_as_float(rr[0]), __uint_as_float(rr[1])); }
  if (__builtin_expect(__all(pmax - m_reg <= THR / SCALE), 1)) { mn = m_reg; alpha = 1.f; }
  else { mn = fmaxf(m_reg, pmax); alpha = __builtin_amdgcn_exp2f((m_reg - mn) * C); m_reg = mn; }
  float mnC = -mn * C;
#pragma unroll
  for (int r = 0; r < 16; ++r) p0[r] = fmaf(p0[r], C, mnC);
#pragma unroll
  for (int r = 0; r < 16; ++r) p1[r] = fmaf(p1[r], C, mnC);
#pragma unroll
  for (int r = 0; r < 16; ++r) p0[r] = __builtin_amdgcn_exp2f(p0[r]);
}
__device__ __forceinline__ void finishSM(f32x16& p0, f32x16& p1, float alpha, float& l_reg, bf16x8& pa0, bf16x8& pa1, bf16x8& pa2, bf16x8& pa3) {
#pragma unroll
  for (int r = 0; r < 16; ++r) p1[r] = __builtin_amdgcn_exp2f(p1[r]);
  float ps = 0;
#pragma unroll
  for (int r = 0; r < 16; ++r) ps += p0[r];
#pragma unroll
  for (int r = 0; r < 16; ++r) ps += p1[r];
  { auto rr = __builtin_amdgcn_permlane32_swap(__float_as_uint(ps), __float_as_uint(ps), false, false);
    ps = __uint_as_float(rr[0]) + __uint_as_float(rr[1]); }
  l_reg = l_reg * alpha + ps;
#define PK4(P, BASE, OUT) do { unsigned a0 = cvt_pk_bf16(P[BASE + 0], P[BASE + 1]), a1 = cvt_pk_bf16(P[BASE + 2], P[BASE + 3]);   \
    unsigned b0 = cvt_pk_bf16(P[BASE + 4], P[BASE + 5]), b1 = cvt_pk_bf16(P[BASE + 6], P[BASE + 7]);                              \
    auto r0 = __builtin_amdgcn_permlane32_swap(a0, b0, false, false); auto r1 = __builtin_amdgcn_permlane32_swap(a1, b1, false, false); \
    u32x4 w = {r0[0], r1[0], r0[1], r1[1]}; OUT = *reinterpret_cast<bf16x8*>(&w); } while (0)
  PK4(p0, 0, pa0); PK4(p0, 8, pa1); PK4(p1, 0, pa2); PK4(p1, 8, pa3);
#undef PK4
}
__device__ __forceinline__ void qkt(f32x16& p0, f32x16& p1, const char* Ks, const bf16x8* qr, int r32, int hi) {
  p0 = f32x16{}; p1 = f32x16{};
#pragma unroll
  for (int d0 = 0; d0 < 8; ++d0) { int cb = (d0 * 16 + hi * 8) * 2;
    bf16x8 b0 = *reinterpret_cast<const bf16x8*>(Ks + KSWZ(r32, cb));
    bf16x8 b1 = *reinterpret_cast<const bf16x8*>(Ks + KSWZ(32 + r32, cb));
    p0 = __builtin_amdgcn_mfma_f32_32x32x16_bf16(b0, qr[d0], p0, 0, 0, 0);
    p1 = __builtin_amdgcn_mfma_f32_32x32x16_bf16(b1, qr[d0], p1, 0, 0, 0); }
}
__device__ __forceinline__ int v_st(int k, int c) { const int kk = (k & ~0xC) | ((k & 4) << 1) | ((k & 8) >> 1); return ((kk >> 3) * 4 + (c >> 5)) * 512 + ((kk & 7) * 32 + (c & 31)) * 2; }
__device__ __forceinline__ int v_rd_base(int lane) { return ((lane & 3) << 3) | (((lane >> 2) & 3) << 6) | (((lane >> 4) & 1) << 5) | (((lane >> 5) & 1) << 8); }
constexpr int v_rd_off(int d0, int ks, int half) { return d0 * 512 + ks * 4096 + half * 2048; }
template <int OFF> __device__ __forceinline__ s16x4 tr_read(int vb) {
  s16x4 r; asm volatile("ds_read_b64_tr_b16 %0, %1 offset:%2" : "=&v"(r) : "v"(vb), "i"(OFF) : "memory"); return r;
}
template <int D0> __device__ __forceinline__ void pv_one(f32x16& od, int vb, bf16x8 pa0, bf16x8 pa1, bf16x8 pa2, bf16x8 pa3) {
  const s16x4 l0 = tr_read<v_rd_off(D0, 0, 0)>(vb), h0 = tr_read<v_rd_off(D0, 0, 1)>(vb), l1 = tr_read<v_rd_off(D0, 1, 0)>(vb), h1 = tr_read<v_rd_off(D0, 1, 1)>(vb);
  const s16x4 l2 = tr_read<v_rd_off(D0, 2, 0)>(vb), h2 = tr_read<v_rd_off(D0, 2, 1)>(vb), l3 = tr_read<v_rd_off(D0, 3, 0)>(vb), h3 = tr_read<v_rd_off(D0, 3, 1)>(vb);
  asm volatile("s_waitcnt lgkmcnt(0)" ::: "memory"); SBAR();
#define PK(L, H) (bf16x8){L[0], L[1], L[2], L[3], H[0], H[1], H[2], H[3]}
  od = __builtin_amdgcn_mfma_f32_32x32x16_bf16(pa0, PK(l0, h0), od, 0, 0, 0);
  od = __builtin_amdgcn_mfma_f32_32x32x16_bf16(pa1, PK(l1, h1), od, 0, 0, 0);
  od = __builtin_amdgcn_mfma_f32_32x32x16_bf16(pa2, PK(l2, h2), od, 0, 0, 0);
  od = __builtin_amdgcn_mfma_f32_32x32x16_bf16(pa3, PK(l3, h3), od, 0, 0, 0);
#undef PK
}
__device__ __forceinline__ void pv_d0(f32x16* o, int vb, bf16x8 pa0, bf16x8 pa1, bf16x8 pa2, bf16x8 pa3) {
  pv_one<0>(o[0], vb, pa0, pa1, pa2, pa3); pv_one<1>(o[1], vb, pa0, pa1, pa2, pa3); pv_one<2>(o[2], vb, pa0, pa1, pa2, pa3); pv_one<3>(o[3], vb, pa0, pa1, pa2, pa3);
}
__device__ __forceinline__ void body(const bf16_t* Qb, const bf16_t* __restrict__ Kh, const bf16_t* __restrict__ Vh, bf16_t* Ob, int seq, char* lds) {
  const int tid = threadIdx.x, wid = tid >> 6, lane = tid & 63, r32 = lane & 31, hi = lane >> 5;
  char* V_lds = lds; char* K_lds = lds + 2 * SHM_V;
  float* ws = (float*)(lds + 2 * SHM_V + 2 * SHM_K) + wid * 64; float* li_l = ws; float* al_l = ws + 32;
  float m_reg = -1e30f, l_reg = 0; f32x16 o[4] = {}; bf16x8 qr[8];
  const bf16_t* Qw = Qb + (long)(wid * QBLK + r32) * LDQ + hi * 8;
#pragma unroll
  for (int d0 = 0; d0 < 8; ++d0) qr[d0] = *reinterpret_cast<const bf16x8*>(Qw + d0 * 16);
  const int sr = tid >> 4, sc = (tid & 15) * 8, vst0 = v_st(sr, sc), vst1 = v_st(32 + sr, sc);
  const int vb0 = (int)(uintptr_t)V_lds + v_rd_base(lane);
  struct { bf16x8 vs0, vs1, ks0, ks1; } sr_[2];
#define SLOAD(i, k0) do { sr_[i].vs0 = *reinterpret_cast<const bf16x8*>(&Vh[(long)((k0) + sr) * LDK + sc]); sr_[i].vs1 = *reinterpret_cast<const bf16x8*>(&Vh[(long)((k0) + 32 + sr) * LDK + sc]); \
    sr_[i].ks0 = *reinterpret_cast<const bf16x8*>(&Kh[(long)((k0) + sr) * LDK + sc]); sr_[i].ks1 = *reinterpret_cast<const bf16x8*>(&Kh[(long)((k0) + 32 + sr) * LDK + sc]); } while (0)
#define SWRITE(b, i) do { *(bf16x8*)(V_lds + (b) * SHM_V + vst0) = sr_[i].vs0;          \
    *(bf16x8*)(V_lds + (b) * SHM_V + vst1) = sr_[i].vs1; int kc = sc * 2;               \
    *(bf16x8*)(K_lds + (b) * SHM_K + KSWZ(sr, kc)) = sr_[i].ks0;                       \
    *(bf16x8*)(K_lds + (b) * SHM_K + KSWZ(32 + sr, kc)) = sr_[i].ks1; } while (0)
#define SWAIT() asm volatile("s_waitcnt vmcnt(4)" ::: "memory")
#define RESC(a) do { if (__any((a) < 1.f)) { if (hi == 0) al_l[r32] = (a); asm volatile("s_waitcnt lgkmcnt(0)" ::: "memory"); \
    _Pragma("unroll") for (int d = 0; d < 4; ++d) _Pragma("unroll") for (int r = 0; r < 16; ++r) o[d][r] *= al_l[crow(r, hi)]; } } while (0)
  f32x16 pA0, pA1, pB0, pB1; float mnA, mnB, alA, alB; bf16x8 pa0, pa1, pa2, pa3; const int NT = seq / KVBLK;
  constexpr int SE = 0, SO = 1;
  SLOAD(SE, 0); asm volatile("s_waitcnt vmcnt(0)" ::: "memory"); SWRITE(0, SE); __syncthreads();
  qkt(pA0, pA1, K_lds, qr, r32, hi); partialSM(pA0, pA1, m_reg, mnA, alA);
  SLOAD(SO, KVBLK); if (2 < NT) SLOAD(SE, 2 * KVBLK);
  SWAIT(); SWRITE(1, SO); __syncthreads();
  for (int j = 1; j + 1 < NT; j += 2) {
    SBAR(); qkt(pB0, pB1, K_lds + SHM_K, qr, r32, hi);
    finishSM(pA0, pA1, alA, l_reg, pa0, pa1, pa2, pa3); SBAR();
    SLOAD(SO, (j + 2) * KVBLK); SBAR();
    pv_d0(o, vb0, pa0, pa1, pa2, pa3); partialSM(pB0, pB1, m_reg, mnB, alB);
    __syncthreads(); SWAIT(); SWRITE(0, SE);
    RESC(alB); __syncthreads();
    SBAR(); qkt(pA0, pA1, K_lds, qr, r32, hi);
    finishSM(pB0, pB1, alB, l_reg, pa0, pa1, pa2, pa3); SBAR();
    if (j + 3 < NT) SLOAD(SE, (j + 3) * KVBLK); SBAR();
    pv_d0(o, vb0 + (int)SHM_V, pa0, pa1, pa2, pa3); partialSM(pA0, pA1, m_reg, mnA, alA);
    __syncthreads(); SWAIT(); SWRITE(1, SO);
    RESC(alA); __syncthreads();
  }
  SBAR(); qkt(pB0, pB1, K_lds + SHM_K, qr, r32, hi);
  finishSM(pA0, pA1, alA, l_reg, pa0, pa1, pa2, pa3); SBAR();
  pv_d0(o, vb0, pa0, pa1, pa2, pa3); partialSM(pB0, pB1, m_reg, mnB, alB);
  __syncthreads(); RESC(alB);
  finishSM(pB0, pB1, alB, l_reg, pa0, pa1, pa2, pa3); SBAR();
  pv_d0(o, vb0 + (int)SHM_V, pa0, pa1, pa2, pa3);
  if (hi == 0) li_l[r32] = l_reg; asm volatile("s_waitcnt lgkmcnt(0)" ::: "memory");
  float rli[16];
#pragma unroll
  for (int r = 0; r < 16; ++r) rli[r] = __builtin_amdgcn_rcpf(li_l[crow(r, hi)]);
  bf16_t* Ow = Ob + (long)(wid * QBLK) * LDO;
#pragma unroll
  for (int r = 0; r < 16; ++r) { int orow = crow(r, hi);
#pragma unroll
    for (int d0 = 0; d0 < 4; ++d0) Ow[(long)orow * LDO + d0 * 32 + r32] = (bf16_t)f2bf(o[d0][r] * rli[r]); }
  __syncthreads();
#undef SLOAD
#undef SWRITE
#undef SWAIT
#undef RESC
}
#undef KSWZ
#undef SBAR
}

__device__ __forceinline__ void p4_mixers(Frame& F) {
    for (int u = blockIdx.x; u < NB * 8; u += F.G) ml::unit(F, u >> 3, u & 7);
#if defined(PROBE_SEL)
    if (blockIdx.x == 0 && F.tid == 0) ((volatile LAS unsigned long long*)(F.lds + MISC_OFF + 4096))[13] = __builtin_amdgcn_s_memrealtime();
#endif
    volatile LAS int* qslot = (volatile LAS int*)(F.lds + MISC_OFF + 64);
    bf16_t* AQ = (bf16_t*)(F.ws + WS_AQ); const bf16_t* AK = (const bf16_t*)(F.ws + WS_AK); const bf16_t* AV = (const bf16_t*)(F.ws + WS_AV);
    for (;;) {
        if (F.tid == 0) *qslot = (int)__hip_atomic_fetch_add((unsigned*)(F.ctl + CW_ATTQ), 1u, RLX_AGENT);
        __syncthreads();
        const int idx = *qslot;
        __syncthreads();
        if (idx >= NB * 8 * 8) break;
        const int b = idx >> 6, kvh = (idx >> 5) & 1, g = (idx >> 3) & 3, qb = idx & 7, head = kvh * 4 + g;
        bf16_t* Q = AQ + (size_t)(b * SEQ + qb * 256) * D + head * 128;
        const bf16_t* K = AK + (size_t)(b * KVL) * 256 + kvh * 128; const bf16_t* V = AV + (size_t)(b * KVL) * 256 + kvh * 128;
        at::body(Q, K, V, Q, KVL, (char*)F.lds);
    }
}

struct RectOrder { static constexpr bool GATHER = false; const char* A; const char* A2; const char* Bt; int nM, nN, K, lda, G, c;
    __device__ __forceinline__ bool next(int i, pg8::Unit& u) const { const long L = (long)i * G + c; if (L >= nM * nN) return false; pg8::tile_of((int)L, nM, nN, u.pm, u.pn); u.x0 = 0; u.x1 = 0; return true; }
    __device__ __forceinline__ const char* aptr(const pg8::Unit& u) const { return A + (size_t)u.pm * 256 * lda * 2; }
    __device__ __forceinline__ const char* aptr2(const pg8::Unit& u) const { return A2 + (size_t)u.pm * 256 * lda * 2; }
    __device__ __forceinline__ const char* bptr(const pg8::Unit& u) const { return Bt + (size_t)u.pn * 256 * K * 2; }
    __device__ __forceinline__ void aoff(const pg8::Unit&, int, unsigned (&)[2][2]) const {}
};
struct EpiMerge { static constexpr bool PERM = true; const bf16_t* mg; bf16_t* Z;
    __device__ __forceinline__ void mid(f32x4 (&acc)[2][2][4][2], const pg8::Unit& u, int wr, int wc, int fr, int fq) const {
        const int row0 = u.pm * 256 + wr * 64 + fr, col0 = u.pn * 256 + wc * 32 + 8 * fq;
#pragma unroll
        for (int ai = 0; ai < 2; ++ai)
#pragma unroll
            for (int m = 0; m < 4; ++m) { const size_t row = (size_t)(row0 + ai * 128 + m * 16);
#pragma unroll
                for (int bj = 0; bj < 2; ++bj) { const int col = col0 + bj * 128;
                    const u32x4 g0 = *(const GAS u32x4*)(mg + row * (2 * D) + col), g1 = *(const GAS u32x4*)(mg + row * (2 * D) + D + col);
                    const unsigned a[4] = {g0.x, g0.y, g0.z, g0.w}, b[4] = {g1.x, g1.y, g1.z, g1.w};
#pragma unroll
                    for (int j = 0; j < 4; ++j) { const float r0 = (1.0f + __expf(-bflo(b[j]))) / (1.0f + __expf(-bflo(a[j]))), r1 = (1.0f + __expf(-bfhi(b[j]))) / (1.0f + __expf(-bfhi(a[j])));
                        acc[ai][bj][m][j >> 1][(2 * j) & 3] *= r0; acc[ai][bj][m][j >> 1][(2 * j + 1) & 3] *= r1; } }
                asm volatile("" ::: "memory"); }
    }
    __device__ __forceinline__ void operator()(const f32x4 (&acc)[2][2][4][2], const pg8::Unit& u, int wr, int wc, int fr, int fq) const {
        const int row0 = u.pm * 256 + wr * 64 + fr, col0 = u.pn * 256 + wc * 32 + 8 * fq;
#pragma unroll
        for (int ai = 0; ai < 2; ++ai)
#pragma unroll
            for (int m = 0; m < 4; ++m) { const size_t row = (size_t)(row0 + ai * 128 + m * 16);
#pragma unroll
                for (int bj = 0; bj < 2; ++bj) { const int col = col0 + bj * 128;
                    const u32x4 gw = *(const GAS u32x4*)(mg + row * (2 * D) + D + col);
                    const f32x4 v0 = acc[ai][bj][m][0], v1 = acc[ai][bj][m][1];
                    u32x4 w; w.x = cvt_pk_bf16(sigmoidf_(bflo(gw.x)) * v0[0], sigmoidf_(bfhi(gw.x)) * v0[1]); w.y = cvt_pk_bf16(sigmoidf_(bflo(gw.y)) * v0[2], sigmoidf_(bfhi(gw.y)) * v0[3]);
                    w.z = cvt_pk_bf16(sigmoidf_(bflo(gw.z)) * v1[0], sigmoidf_(bfhi(gw.z)) * v1[1]); w.w = cvt_pk_bf16(sigmoidf_(bflo(gw.w)) * v1[2], sigmoidf_(bfhi(gw.w)) * v1[3]);
                    *(GAS u32x4*)(Z + row * D + col) = w; }
                asm volatile("" ::: "memory"); }
    }
};
struct EpiOut { static constexpr bool PERM = false; const float* x; const float* mod; float* out;
    __device__ __forceinline__ void operator()(const f32x4 (&acc)[2][2][4][2], const pg8::Unit& u, int wr, int wc, int fr, int fq) const {
        const int row0 = u.pm * 256 + wr * 64 + fr, col0 = u.pn * 256 + wc * 32 + 4 * fq; const float* g1 = mod + (size_t)((u.pm * 256) / SEQ) * NMOD + 2 * D;
#pragma unroll
        for (int ai = 0; ai < 2; ++ai)
#pragma unroll
            for (int m = 0; m < 4; ++m) { const size_t ro = (size_t)(row0 + ai * 128 + m * 16) * D;
#pragma unroll
                for (int bj = 0; bj < 2; ++bj)
#pragma unroll
                    for (int n = 0; n < 2; ++n) { const int col = col0 + bj * 128 + n * 16;
                        const f32x4 xv = *(const GAS f32x4*)(x + ro + col), gv = *(const f32x4*)(g1 + col);
                        *(GAS f32x4*)(out + ro + col) = xv + gv * acc[ai][bj][m][n]; }
                asm volatile("" ::: "memory"); }
    }
};

struct DrGU { int up; __device__ __forceinline__ int operator()(int j) const { return 256 * (j >> 7) + 128 * ((j >> 6) & 1) + 32 * ((j >> 4) & 3) + 8 * ((j >> 2) & 3) + 4 * up + (j & 3); } };
__device__ __forceinline__ void p6_fl(Frame& F) {
    const int gw = F.vcu * NWAVES + F.wave, NGW = F.G * NWAVES;
    {
        LAS float* scr = (LAS float*)(F.lds + F.wave * 16384);
        bf16_t* wgu = (bf16_t*)(F.ws + WS_WGU); bf16_t* wd = (bf16_t*)(F.ws + WS_WD);
        constexpr int I_G = 16 * 8, I_D = 4 * 32, PER_E = 2 * I_G + I_D;
        for (int it = gw; it < NEXP * PER_E; it += NGW) { const int e = it / PER_E; int r = it % PER_E;
            if (r < I_G) { transpose_item(F.in[IN_WEG] + (size_t)e * D * DEXP, D, DEXP, wgu + (size_t)e * 512 * D, DrGU{0}, scr, r, F.lane); continue; } r -= I_G;
            if (r < I_G) { transpose_item(F.in[IN_WEU] + (size_t)e * D * DEXP, D, DEXP, wgu + (size_t)e * 512 * D, DrGU{1}, scr, r, F.lane); continue; } r -= I_G;
            transpose_item(F.in[IN_WED] + (size_t)e * DEXP * D, DEXP, D, wd + (size_t)e * D * DEXP, DrIdent{0}, scr, r, F.lane); }
    }
    const float* mod = (const float*)(F.ws + WS_MOD); const float* n2w = F.in[IN_N2W]; bf16_t* FL = (bf16_t*)(F.ws + WS_FL);
    for (int row = gw; row < T_LAT; row += NGW) {
        const int b = row / SEQ;
        const GAS f32x4* hr = (const GAS f32x4*)(F.out + (size_t)row * D) + F.lane;
        f32x4 v[4]; float s = 0.f;
#pragma unroll
        for (int j = 0; j < 4; ++j) { v[j] = hr[64 * j]; s += (v[j].x * v[j].x + v[j].y * v[j].y) + (v[j].z * v[j].z + v[j].w * v[j].w); }
        const float rinv = 1.0f / sqrtf(wave_sum(s) * (1.0f / D) + EPS);
        GAS u32x2* o8 = (GAS u32x2*)(FL + (size_t)row * D) + F.lane;
#pragma unroll
        for (int j = 0; j < 4; ++j) { const int col = 256 * j + 4 * F.lane;
            const f32x4 w = *(const f32x4*)(n2w + col), sh = *(const f32x4*)(mod + b * NMOD + 3 * D + col), sc = *(const f32x4*)(mod + b * NMOD + 4 * D + col);
            v[j] = (v[j] * rinv) * w * (sc + 1.0f) + sh;
            u32x2 o; o.x = pk2(v[j].x, v[j].y); o.y = pk2(v[j].z, v[j].w); o8[64 * j] = o; }
    }
}
struct EpiLogits { static constexpr bool PERM = false; float* LG;
    __device__ __forceinline__ void operator()(const f32x4 (&acc)[2][2][4][2], const pg8::Unit& u, int wr, int wc, int fr, int fq) const {
        const int row0 = u.pm * 256 + wr * 64 + fr, col0 = wc * 32 + 4 * fq;
#pragma unroll
        for (int ai = 0; ai < 2; ++ai)
#pragma unroll
            for (int m = 0; m < 4; ++m) { float* p = LG + (size_t)(row0 + ai * 128 + m * 16) * 128 + col0;
                *(GAS f32x4*)p = acc[ai][0][m][0]; *(GAS f32x4*)(p + 16) = acc[ai][0][m][1]; }
    }
};
__device__ __forceinline__ void p8_route(Frame& F) {
    const float* LG = (const float*)(F.ws + WS_LG); const float* brg = F.in[IN_BRG]; const float* bre = F.in[IN_BRE];
    unsigned* eid = (unsigned*)(F.ws + WS_ROUT); float* wts = (float*)(F.ws + WS_ROUT) + 2 * T_LAT; unsigned* lists = (unsigned*)(F.ws + WS_LISTS);
    for (int row = blockIdx.x * NTHREADS + F.tid; row < T_LAT; row += F.G * NTHREADS) {
        const float* lp = LG + (size_t)row * 128;
        const f32x4 gh = *(const GAS f32x4*)lp, gl4 = *(const GAS f32x4*)(lp + 64);
        float gl[4] = {gh.x + gl4.x + brg[0], gh.y + gl4.y + brg[1], gh.z + gl4.z + brg[2], gh.w + gl4.w + brg[3]};
        int gs = 0; float gm = gl[0];
#pragma unroll
        for (int g = 1; g < 4; ++g) if (gl[g] > gm) { gm = gl[g]; gs = g; }
        float den = 0.f;
#pragma unroll
        for (int g = 0; g < 4; ++g) den += expf(gl[g] - gm);
        const float pgrp = 1.0f / den;
        const f32x4 h0 = *(const GAS f32x4*)(lp + 4 + 8 * gs), h1 = *(const GAS f32x4*)(lp + 8 + 8 * gs), l0 = *(const GAS f32x4*)(lp + 68 + 8 * gs), l1 = *(const GAS f32x4*)(lp + 72 + 8 * gs);
        const f32x4 b0 = *(const f32x4*)(bre + 8 * gs), b1 = *(const f32x4*)(bre + 8 * gs + 4);
        const float el[8] = {h0.x + l0.x + b0.x, h0.y + l0.y + b0.y, h0.z + l0.z + b0.z, h0.w + l0.w + b0.w, h1.x + l1.x + b1.x, h1.y + l1.y + b1.y, h1.z + l1.z + b1.z, h1.w + l1.w + b1.w};
        int i0 = 0; float v0 = el[0];
#pragma unroll
        for (int j = 1; j < 8; ++j) if (el[j] > v0) { v0 = el[j]; i0 = j; }
        int i1 = -1; float v1 = -3.0e38f;
#pragma unroll
        for (int j = 0; j < 8; ++j) if (j != i0 && el[j] > v1) { v1 = el[j]; i1 = j; }
        const float e1 = expf(v1 - v0), w0 = pgrp / (1.0f + e1), w1 = pgrp * e1 / (1.0f + e1);
        const int ex0 = gs * 8 + i0, ex1 = gs * 8 + i1;
        const unsigned p0 = __hip_atomic_fetch_add((unsigned*)(F.ctl + CW_CNT + ex0 * 64), 1u, RLX_AGENT);
        const unsigned p1 = __hip_atomic_fetch_add((unsigned*)(F.ctl + CW_CNT + (32 + ex1) * 64), 1u, RLX_AGENT);
        lists[(size_t)ex0 * T_LAT + p0] = (unsigned)row; lists[(size_t)(32 + ex1) * T_LAT + p1] = (unsigned)row;
        eid[row] = (unsigned)ex0; eid[T_LAT + row] = (unsigned)ex1; wts[row] = w0; wts[T_LAT + row] = w1;
    }
}

__device__ __forceinline__ void moe_table(Frame& F) {
    volatile LAS int* ts = (volatile LAS int*)(F.lds + MISC_OFF + 256); volatile LAS int* cn = ts + 80;
    if (F.tid < 64) cn[F.tid] = (int)__hip_atomic_load((unsigned*)(F.ctl + CW_CNT + F.tid * 64), RLX_AGENT);
    __syncthreads();
    if (F.tid == 0) { int a = 0; for (int g = 0; g < 64; ++g) { ts[g] = a; a += (cn[g] + 255) >> 8; } ts[64] = a; }
    __syncthreads();
}
struct Moe1Order { static constexpr bool GATHER = true; const char* FLb; const char* Wgu; const unsigned* lists; const LAS int* ts; const LAS int* cn; int G, c;
    __device__ __forceinline__ bool next(int i, pg8::Unit& u) const { const long L = (long)i * G + c; const int T = (int)(L >> 1); if (T >= ts[64]) return false;
        int g = 0; while (ts[g + 1] <= T) ++g;
        u.pm = T; u.pn = (int)(L & 1); u.x0 = g; u.x1 = (T - ts[g]) * 256; return true; }
    __device__ __forceinline__ const char* aptr(const pg8::Unit&) const { return FLb; }
    __device__ __forceinline__ const char* bptr(const pg8::Unit& u) const { return Wgu + ((size_t)(u.x0 & 31) * 512 + (size_t)u.pn * 256) * D * 2; }
    __device__ __forceinline__ void aoff(const pg8::Unit& u, int tid, unsigned (&off)[2][2]) const { const int n = cn[u.x0];
#pragma unroll
        for (int i = 0; i < 2; ++i) { int R, C; pg8::stage_rc(tid * 16 + i * 8192, R, C);
#pragma unroll
            for (int h = 0; h < 2; ++h) { const int idx = u.x1 + h * 128 + R; const unsigned tok = idx < n ? lists[(size_t)u.x0 * T_LAT + idx] : 0u; off[h][i] = tok * (unsigned)(D * 2) + (unsigned)(C * 2); } } }
};
struct EpiMoe1 { static constexpr bool PERM = true; bf16_t* H;
    __device__ __forceinline__ void operator()(const f32x4 (&acc)[2][2][4][2], const pg8::Unit& u, int wr, int wc, int fr, int fq) const {
        const int row0 = u.pm * 256 + wr * 64 + fr, col0 = u.pn * 128 + 16 * wc + 4 * fq;
#pragma unroll
        for (int ai = 0; ai < 2; ++ai)
#pragma unroll
            for (int m = 0; m < 4; ++m)
#pragma unroll
                for (int bj = 0; bj < 2; ++bj) { const f32x4 g = acc[ai][bj][m][0], up = acc[ai][bj][m][1];
                    u32x2 w; w.x = cvt_pk_bf16(siluf_(g[0]) * up[0], siluf_(g[1]) * up[1]); w.y = cvt_pk_bf16(siluf_(g[2]) * up[2], siluf_(g[3]) * up[3]);
                    *(GAS u32x2*)(H + (size_t)(row0 + ai * 128 + m * 16) * DEXP + col0 + 64 * bj) = w; }
    }
};
struct Moe2Order { static constexpr bool GATHER = false; const char* Hb; const char* Wd; const LAS int* ts; const LAS int* cn; int slot, G, c;
    __device__ __forceinline__ bool next(int i, pg8::Unit& u) const { const long L = (long)i * G + c; const int T = ts[slot * 32] + (int)(L >> 2); if (T >= ts[slot * 32 + 32]) return false;
        int g = slot * 32; while (ts[g + 1] <= T) ++g;
        u.pm = T; u.pn = (int)(L & 3); u.x0 = g; u.x1 = (T - ts[g]) * 256; return true; }
    __device__ __forceinline__ const char* aptr(const pg8::Unit& u) const { return Hb + (size_t)u.pm * 256 * DEXP * 2; }
    __device__ __forceinline__ const char* bptr(const pg8::Unit& u) const { return Wd + ((size_t)(u.x0 & 31) * D + (size_t)u.pn * 256) * DEXP * 2; }
    __device__ __forceinline__ void aoff(const pg8::Unit&, int, unsigned (&)[2][2]) const {}
};
struct EpiMoe2 { static constexpr bool PERM = false; float* out; const float* mod; const unsigned* lists; const float* wts; const LAS int* cn; int slot;
    __device__ __forceinline__ void operator()(const f32x4 (&acc)[2][2][4][2], const pg8::Unit& u, int wr, int wc, int fr, int fq) const {
        const int n = cn[u.x0], col0 = u.pn * 256 + wc * 32 + 4 * fq;
#pragma unroll
        for (int ai = 0; ai < 2; ++ai)
#pragma unroll
            for (int m = 0; m < 4; ++m) { const int idx = u.x1 + ai * 128 + wr * 64 + m * 16 + fr;
                if (idx < n) { const unsigned tok = lists[(size_t)u.x0 * T_LAT + idx]; const float w = wts[(size_t)slot * T_LAT + tok]; const float* g2 = mod + (size_t)(tok / SEQ) * NMOD + 5 * D; float* op = out + (size_t)tok * D;
#pragma unroll
                    for (int bj = 0; bj < 2; ++bj)
#pragma unroll
                        for (int nn = 0; nn < 2; ++nn) { const int col = col0 + bj * 128 + nn * 16; const f32x4 gv = *(const f32x4*)(g2 + col); const f32x4 ov = *(const GAS f32x4*)(op + col);
                            *(GAS f32x4*)(op + col) = ov + (gv * w) * acc[ai][bj][m][nn]; } }
                asm volatile("" ::: "memory"); }
    }
};

#ifndef MK_N_LAUNCHES
#define MK_N_LAUNCHES 1
#endif
constexpr int N_PHASES = 12;
constexpr int N_LAUNCHES = MK_N_LAUNCHES;
struct Args { const float* in[23]; float* out; unsigned char* ws; int ph_lo, ph_hi, kd, pad; };
__global__ void __launch_bounds__(NTHREADS, 2) fwd_kernel(Args args) {
    extern __shared__ __attribute__((aligned(16))) unsigned char lds[];
    Frame F;
    F.lds = (LAS unsigned char*)lds;
    F.tid = threadIdx.x; F.lane = F.tid & 63; F.wave = __builtin_amdgcn_readfirstlane(F.tid >> 6);
    F.G = gridDim.x; { const int bx = blockIdx.x; F.vcu = (F.G % 8 == 0) ? (bx % 8) * (F.G / 8) + bx / 8 : bx; }
    F.ws = args.ws; F.out = args.out; F.ctl = (gu32*)(args.ws + WS_CTL);
#pragma unroll
    for (int i = 0; i < 23; ++i) F.in[i] = args.in[i];
    for (int u = F.tid; u < (LDS_BYTES - MISC_OFF) / 4; u += NTHREADS) ((LAS unsigned*)(F.lds + MISC_OFF))[u] = 0u;
    __syncthreads();
    XcdBarrier bar; bar.bar = (unsigned*)(F.ctl + CW_BAR); bar.x = 0; bar.st = nullptr;
    if (N_LAUNCHES == 1) bar = xcd_barrier_post((unsigned*)(F.ctl + CW_BAR), (volatile LAS unsigned*)(F.lds + MISC_OFF + 32));
    const int lo = args.ph_lo, hi = args.ph_hi;
#ifndef PH_MASK
#define PH_MASK 0xFFF
#endif
#define IN(k) ((((PH_MASK) >> (k)) & 1) && lo <= (k) && (k) < hi)
#define SEAM(k) do { if (IN(k) && IN((k) + 1)) xcd_barrier(bar); STAMP((k) + 1); } while (0)
#if defined(PROBE_SEL)
#define STAMP(k) do { if (blockIdx.x == 0 && F.tid == 0) ((volatile LAS unsigned long long*)(F.lds + MISC_OFF + 4096))[k] = __builtin_amdgcn_s_memrealtime(); } while (0)
#else
#define STAMP(k) do { } while (0)
#endif
    STAMP(0);

    if (IN(0)) { p0_prologue(F); } SEAM(0);
    if (IN(1)) { p1_a0(F); } SEAM(1);
    if (IN(2)) {
        InProjOrder S{(const char*)(F.ws + WS_A0), (const char*)(F.ws + WS_WIN), F.G, (int)blockIdx.x};
        EpiInProj E{F.ws, (bf16_t*)F.out, F.in[IN_BMG], F.in[IN_QNW], F.in[IN_KNW], F.lds};
        pg8::gemm_phase<EpiInProj, InProjOrder, true>(F.lds, D, S, E);
    } SEAM(2);
    if (IN(3)) { p4_mixers(F); } SEAM(3);
    if (IN(4)) {
        RectOrder S{(const char*)(F.ws + WS_MQ), (const char*)(F.ws + WS_AQ), (const char*)(F.ws + WS_WBM), MT_LAT, 4, 2 * D, D, F.G, (int)blockIdx.x};
        EpiMerge E{(const bf16_t*)F.out, (bf16_t*)(F.ws + WS_Z)};
        pg8::gemm_phase<EpiMerge, RectOrder, true, true>(F.lds, 2 * D, S, E);
    } SEAM(4);
    if (IN(5)) {
        RectOrder S{(const char*)(F.ws + WS_Z), nullptr, (const char*)(F.ws + WS_WO), MT_LAT, 4, D, D, F.G, (int)blockIdx.x};
        EpiOut E{F.in[IN_X], (const float*)(F.ws + WS_MOD), F.out};
        pg8::gemm_phase<EpiOut, RectOrder, true>(F.lds, D, S, E);
    } SEAM(5);
    if (IN(6)) { p6_fl(F); } SEAM(6);
    if (IN(7)) {
        RectOrder S{(const char*)(F.ws + WS_FL), nullptr, (const char*)(F.ws + WS_WR), MT_LAT, 1, D, D, F.G, (int)blockIdx.x};
        EpiLogits E{(float*)(F.ws + WS_LG)};
        pg8::gemm_phase<EpiLogits, RectOrder, true>(F.lds, D, S, E);
    } SEAM(7);
    if (IN(8)) { p8_route(F); } SEAM(8);
    if (IN(9)) {
        moe_table(F);
        const LAS int* ts = (const LAS int*)(F.lds + MISC_OFF + 256);
        Moe1Order S{(const char*)(F.ws + WS_FL), (const char*)(F.ws + WS_WGU), (const unsigned*)(F.ws + WS_LISTS), ts, ts + 80, F.G, (int)blockIdx.x};
        EpiMoe1 E{(bf16_t*)(F.ws + WS_H)};
        pg8::gemm_phase<EpiMoe1, Moe1Order, true>(F.lds, D, S, E);
    } SEAM(9);
    if (IN(10)) {
        moe_table(F);
        const LAS int* ts = (const LAS int*)(F.lds + MISC_OFF + 256);
        Moe2Order S{(const char*)(F.ws + WS_H), (const char*)(F.ws + WS_WD), ts, ts + 80, 0, F.G, (int)blockIdx.x};
        EpiMoe2 E{F.out, (const float*)(F.ws + WS_MOD), (const unsigned*)(F.ws + WS_LISTS), (const float*)(F.ws + WS_ROUT) + 2 * T_LAT, ts + 80, 0};
        pg8::gemm_phase<EpiMoe2, Moe2Order, true>(F.lds, args.kd, S, E);
    } SEAM(10);
    if (IN(11)) {
        moe_table(F);
        const LAS int* ts = (const LAS int*)(F.lds + MISC_OFF + 256);
        Moe2Order S{(const char*)(F.ws + WS_H), (const char*)(F.ws + WS_WD), ts, ts + 80, 1, F.G, (int)blockIdx.x};
        EpiMoe2 E{F.out, (const float*)(F.ws + WS_MOD), (const unsigned*)(F.ws + WS_LISTS), (const float*)(F.ws + WS_ROUT) + 2 * T_LAT, ts + 80, 1};
        pg8::gemm_phase<EpiMoe2, Moe2Order, true>(F.lds, args.kd, S, E);
    }
#if defined(PROBE_SEL)
    STAMP(12);
    if (blockIdx.x == 0 && F.tid == 0) { volatile LAS unsigned long long* ts = (volatile LAS unsigned long long*)(F.lds + MISC_OFF + 4096);
        const unsigned long long dt = (PROBE_SEL == 13 ? ts[13] - ts[3] : ts[PROBE_SEL + 1] - ts[PROBE_SEL]) * PROBE_MULT; const unsigned long long t0 = __builtin_amdgcn_s_memrealtime();
        while (__builtin_amdgcn_s_memrealtime() - t0 < dt) __builtin_amdgcn_s_sleep(8); }
#endif
#undef IN
#undef SEAM
}

extern "C" void kernel_launch(void* const* d_in, const int* in_sizes, int n_in, void* d_out, int out_size, void* d_ws, size_t ws_size, hipStream_t stream) {
    static int grid = 0;
    if (grid == 0) {
        if (n_in != 23 || out_size != T_LAT * D || ws_size < WS_END) { fprintf(stderr, "kernel_launch: unexpected shapes (n_in %d out %d ws %zu)\n", n_in, out_size, ws_size); grid = -1; return; }
        int dev = 0, cus = 0;
        if (hipGetDevice(&dev) != hipSuccess || hipDeviceGetAttribute(&cus, hipDeviceAttributeMultiprocessorCount, dev) != hipSuccess) { grid = -1; return; }
        if (hipFuncSetAttribute((const void*)fwd_kernel, hipFuncAttributeMaxDynamicSharedMemorySize, LDS_BYTES) != hipSuccess) { fprintf(stderr, "kernel_launch: hipFuncSetAttribute failed\n"); grid = -1; return; }
        int per_cu = 0;
        if (hipOccupancyMaxActiveBlocksPerMultiprocessor(&per_cu, (const void*)fwd_kernel, NTHREADS, LDS_BYTES) != hipSuccess || per_cu < 1) fprintf(stderr, "kernel_launch: occupancy query says %d\n", per_cu);
        (void)hipGetLastError();
        grid = cus;
    }
    if (grid < 0) return;
    if (hipMemsetAsync((char*)d_ws + WS_CTL, 0, CTL_ZERO_BYTES, stream) != hipSuccess) return;
    Args a{};
    for (int i = 0; i < 23; ++i) a.in[i] = (const float*)d_in[i];
    a.out = (float*)d_out; a.ws = (unsigned char*)d_ws; a.kd = DEXP; a.pad = 0;
    if (N_LAUNCHES == 1) { a.ph_lo = 0; a.ph_hi = N_PHASES; hipLaunchKernelGGL(fwd_kernel, dim3(grid), dim3(NTHREADS), LDS_BYTES, stream, a); }
    else for (int p = 0; p < N_PHASES; ++p) { a.ph_lo = p; a.ph_hi = p + 1; hipLaunchKernelGGL(fwd_kernel, dim3(grid), dim3(NTHREADS), LDS_BYTES, stream, a); }
    const hipError_t le = hipPeekAtLastError();
    if (le != hipSuccess) fprintf(stderr, "kernel_launch: launch failed: %s\n", hipGetErrorName(le));
}
```

```cpp
#include <hip/hip_runtime.h>
#include <cstdio>
#include <cstdint>

#define LAS __attribute__((address_space(3)))
#define GAS __attribute__((address_space(1)))
typedef unsigned short bf16_t;
typedef short bf16x8 __attribute__((ext_vector_type(8)));
typedef short s16x4 __attribute__((ext_vector_type(4)));
typedef float f32x4 __attribute__((ext_vector_type(4)));
typedef float f32x2 __attribute__((ext_vector_type(2)));
typedef float f32x16 __attribute__((ext_vector_type(16)));
typedef unsigned u32x4 __attribute__((ext_vector_type(4)));
typedef unsigned u32x2 __attribute__((ext_vector_type(2)));
typedef GAS unsigned gu32;

constexpr int D = 1024, NB = 16, SEQ = 2048, CTXL = 256;
constexpr int T_LAT = NB * SEQ, T_CTX = NB * CTXL, T_ALL = T_LAT + T_CTX;
constexpr int IN_W = 7712, NMOD = 6 * D;
constexpr int KVL = SEQ + CTXL;
constexpr int NEXP = 32, DEXP = 256;
constexpr float EPS = 1e-6f;
constexpr int NWAVES = 8, NTHREADS = 512;

constexpr int NT_LAT = 31, NT_CTX = 11, NW_IN = NT_LAT * 256;
constexpr int MT_LAT = T_LAT / 256, MT_CTX = T_CTX / 256;

constexpr size_t MiB = 1u << 20;
constexpr size_t WS_CTL = 0, CTL_ZERO_BYTES = 1 * MiB;
constexpr size_t WS_MOD = 1 * MiB;
constexpr size_t WS_ROPE = 1 * MiB + 512 * 1024;
constexpr size_t WS_GATES = 2 * MiB;
constexpr size_t WS_WBM = 7 * MiB, WS_WO = 11 * MiB;
constexpr size_t WS_WR = 28 * MiB + 512 * 1024;
constexpr size_t WS_WIN = 13 * MiB;
constexpr size_t WS_ROUT = 29 * MiB;
constexpr size_t WS_LISTS = 30 * MiB;
constexpr size_t WS_A0 = 38 * MiB;
constexpr size_t WS_MQ = 110 * MiB;
constexpr size_t WS_MK = 174 * MiB;
constexpr size_t WS_MV = 246 * MiB;
constexpr size_t WS_OG = 318 * MiB;
constexpr size_t WS_AQ = 382 * MiB;
constexpr size_t WS_AK = 446 * MiB;
constexpr size_t WS_AV = 464 * MiB;
constexpr size_t WS_END = 482 * MiB;
constexpr size_t WS_WGU = WS_A0, WS_WD = WS_A0 + 32 * MiB;
constexpr size_t WS_Z = WS_MK, WS_FL = WS_MV, WS_H = WS_OG, WS_HTMP = WS_A0;
constexpr size_t WS_LG = WS_AK;

constexpr int CW_TMO = 0, CW_ATTQ = 64, CW_BAR = 4096;
constexpr int CW_CNT = 8192;
constexpr int LDS_BYTES = 155648;
constexpr int MISC_OFF = 147456;

#define RLX_AGENT __ATOMIC_RELAXED, __HIP_MEMORY_SCOPE_AGENT
#define LDS_WAIT() asm volatile("s_waitcnt lgkmcnt(0)" ::: "memory")
#define VM_WAIT() asm volatile("s_waitcnt vmcnt(0)" ::: "memory")

__device__ __forceinline__ unsigned f2bf(float f) { unsigned u = __builtin_bit_cast(unsigned, f); return (u + 0x7fffu + ((u >> 16) & 1u)) >> 16; }
__device__ __forceinline__ unsigned pk2(float lo, float hi) { return f2bf(lo) | (f2bf(hi) << 16); }
__device__ __forceinline__ float bf2f(unsigned short b) { return __builtin_bit_cast(float, ((unsigned)b) << 16); }
__device__ __forceinline__ float bflo(unsigned w) { return __builtin_bit_cast(float, w << 16); }
__device__ __forceinline__ float bfhi(unsigned w) { return __builtin_bit_cast(float, w & 0xffff0000u); }
typedef __bf16 bf16x2_t __attribute__((ext_vector_type(2)));
__device__ __forceinline__ unsigned cvt_pk_bf16(float lo, float hi) { const f32x2 v = {lo, hi}; const bf16x2_t b = __builtin_convertvector(v, bf16x2_t); return __builtin_bit_cast(unsigned, b); }
__device__ __forceinline__ float wave_sum(float v) {
#pragma unroll
    for (int o = 1; o < 64; o <<= 1) v += __shfl_xor(v, o);
    return v;
}
__device__ __forceinline__ float wave_max(float v) {
#pragma unroll
    for (int o = 1; o < 64; o <<= 1) v = fmaxf(v, __shfl_xor(v, o));
    return v;
}
__device__ __forceinline__ float sigmoidf_(float x) { return 1.0f / (1.0f + __expf(-x)); }
__device__ __forceinline__ float siluf_(float x) { return x / (1.0f + __expf(-x)); }

#define XB_TMO      128
#define XB_XCNT(j)  (256  + 64 * (j))
#define XB_XSUB(j)  (1280 + 64 * (j))
#define XB_XGEN(j)  (2304 + 64 * (j))
#define XB_TOP      3328
#define XB_TOPGEN   3392
#define XCD_BAR_WORDS 3456
#define XB_SPIN_CAP (1u << 18)

__device__ __forceinline__ unsigned xb_ld(unsigned* p)              { return __hip_atomic_load(p, __ATOMIC_RELAXED, __HIP_MEMORY_SCOPE_AGENT); }
__device__ __forceinline__ unsigned xb_add(unsigned* p, unsigned v) { return __hip_atomic_fetch_add(p, v, __ATOMIC_RELAXED, __HIP_MEMORY_SCOPE_AGENT); }
__device__ __forceinline__ unsigned xb_xcc_id() { return (unsigned)__builtin_amdgcn_s_getreg((3 << 11) | 20) & 0xFu; }
#define XB_SPIN(cond, bar) do { unsigned _sp = 0; while (cond) { __builtin_amdgcn_s_sleep(1); \
    if ((++_sp & 255u) == 0u) { if (xb_ld(&(bar)[XB_TMO])) break; if (_sp > XB_SPIN_CAP) { atomicAdd(&(bar)[XB_TMO], 1u); break; } } } } while (0)

struct XcdBarrier {
    unsigned* bar; unsigned x;
    volatile LAS unsigned* st;
};

__device__ __forceinline__ XcdBarrier xcd_barrier_post(unsigned* bar, volatile LAS unsigned* st) {
    XcdBarrier b; b.bar = bar; b.x = xb_xcc_id(); b.st = st;
    if (threadIdx.x == 0) (void)xb_add(&bar[XB_XCNT(b.x)], 1u);
    return b;
}
__device__ __forceinline__ void xcd_barrier_complete(unsigned* bar, unsigned x, unsigned& nloc, unsigned& nx) {
    const unsigned G = gridDim.x * gridDim.y * gridDim.z;
    unsigned sum, cnt, mine, sp = 0u;
    for (;;) {
        sum = 0u; cnt = 0u; mine = 0u;
#pragma unroll
        for (unsigned j = 0; j < 16; ++j) { const unsigned c = xb_ld(&bar[XB_XCNT(j)]); sum += c; cnt += (c > 0u) ? 1u : 0u; mine = (j == x) ? c : mine; }
        if (sum == G) break;
        __builtin_amdgcn_s_sleep(1);
        if ((++sp & 255u) == 0u) { if (xb_ld(&bar[XB_TMO])) break; if (sp > XB_SPIN_CAP) { atomicAdd(&bar[XB_TMO], 1u); break; } }
    }
    nloc = mine > 0u ? mine : 1u; nx = cnt > 0u ? cnt : 1u;
}

__device__ __forceinline__ void xcd_barrier(const XcdBarrier& b) {
    asm volatile("s_waitcnt vmcnt(0)" ::: "memory");
    __syncthreads();
    if (threadIdx.x == 0) {
        unsigned* bar = b.bar;
        __builtin_amdgcn_s_waitcnt(0);
        unsigned nloc = b.st[0], nx = b.st[1];
        if (nloc == 0u) { xcd_barrier_complete(bar, b.x, nloc, nx); b.st[0] = nloc; b.st[1] = nx; }
        const unsigned old = xb_add(&bar[XB_XSUB(b.x)], 1u);
        const unsigned gen = old / nloc;
        if (old + 1u == (gen + 1u) * nloc) {
            __builtin_amdgcn_fence(__ATOMIC_RELEASE, "agent");
            asm volatile("s_waitcnt vmcnt(0)" ::: "memory");
            const unsigned og = xb_add(&bar[XB_TOP], 1u);
            const unsigned tg = og / nx;
            if (og + 1u == (tg + 1u) * nx) xb_add(&bar[XB_TOPGEN], 1u);
            else XB_SPIN(xb_ld(&bar[XB_TOPGEN]) == tg, bar);
            __builtin_amdgcn_fence(__ATOMIC_ACQUIRE, "agent");
            xb_add(&bar[XB_XGEN(b.x)], 1u);
            asm volatile("s_waitcnt vmcnt(0)" ::: "memory");
        } else {
            XB_SPIN(xb_ld(&bar[XB_XGEN(b.x)]) == gen, bar);
            __builtin_amdgcn_fence(__ATOMIC_ACQUIRE, "agent");
            asm volatile("s_waitcnt vmcnt(0)" ::: "memory");
        }
    }
    __syncthreads();
}

namespace pg8 {
constexpr int BM = 256, BK = 64, HALF = 128, HTB = HALF * BK * 2  , STAGE_BYTES = 8 * HTB, NXCD = 8, WGM = 8;
__host__ __device__ __forceinline__ int lds_byte(int r, int c) { const int st = (r >> 4) * 2 + (c >> 5), rr = r & 15, cc = c & 31, ob = rr * 64 + cc * 2; return st * 1024 + (ob ^ (((ob >> 9) & 1) << 5)); }
__host__ __device__ __forceinline__ void stage_rc(int b, int& R, int& C) { const int st = b / 1024, sb = b % 1024, swz = sb ^ (((sb >> 9) & 1) << 5); R = (st >> 1) * 16 + swz / 64; C = (st & 1) * 32 + (swz % 64) / 2; }
__host__ __device__ __forceinline__ int perm32(int rho) { const int n = rho >> 4, i = rho & 15; return 8 * (i >> 2) + 4 * n + (i & 3); }

struct Unit { int pm, pn, x0, x1; };
__device__ __forceinline__ void tile_of(int wgid, int nM, int nN, int& pm, int& pn) {
    const int nwg = nM * nN; { const int q = nwg / NXCD, r = nwg % NXCD, xcd = wgid % NXCD, off = wgid / NXCD; wgid = (xcd < r ? xcd * (q + 1) : r * (q + 1) + (xcd - r) * q) + off; }
    const int nig = WGM * nN, gid = wgid / nig, fm = gid * WGM, gsz = (nM - fm) < WGM ? (nM - fm) : WGM;
    pm = fm + ((wgid % nig) % gsz); pn = (wgid % nig) / gsz;
}

template <class Epi, class Sched, bool ALIGN_EPI, bool DUAL = false>
__device__ __forceinline__ void gemm_phase(LAS unsigned char* lds, const int K, const Sched& S, const Epi& E) {
    const int tid = threadIdx.x, wid = __builtin_amdgcn_readfirstlane(tid >> 6), lane = tid & 63, wr = wid >> 2, wc = wid & 3, fr = lane & 15, fq = lane >> 4;
    const int nt = K / BK;
    unsigned voffA[2], voffB[2];
#pragma unroll
    for (int i = 0; i < 2; ++i) { int R, C; stage_rc(tid * 16 + i * 8192, R, C); const int Rb = Epi::PERM ? ((R & ~31) + perm32(R & 31)) : R;
        voffA[i] = (unsigned)(R * (DUAL ? K / 2 : K) + C) * 2u; voffB[i] = (unsigned)(Rb * K + C) * 2u; }
    const size_t kstep = (size_t)(BK * 2);
    const size_t hstep = (size_t)HALF * K * 2;
    const size_t hstepA = (size_t)HALF * (DUAL ? K / 2 : K) * 2;
    const unsigned ldsw = (unsigned)wid * 1024u;
    const int aoff = lds_byte(wr * 64 + fr, fq * 8), boff = lds_byte(wc * 32 + fr, fq * 8);
#define PG8_SA(b, h) (((b) * 2 + (h)) * HTB)
#define PG8_SB(b, h) ((4 + (b) * 2 + (h)) * HTB)
#define PG8_STAGE(bufoff, gbase, voff) do { _Pragma("unroll") for (int _i = 0; _i < 2; ++_i) \
        __builtin_amdgcn_global_load_lds((const unsigned*)((const char*)(gbase) + (voff)[_i]), (LAS unsigned*)(lds + (bufoff) + ldsw + _i * 8192), 16, 0, 0); } while (0)
#define PG8_STAGE_A(bufoff, base, h, NX) do { if constexpr (Sched::GATHER) { _Pragma("unroll") for (int _i = 0; _i < 2; ++_i) { const unsigned _o = (NX) ? gN[h][_i] : gA[h][_i]; \
        __builtin_amdgcn_global_load_lds((const unsigned*)((const char*)(base) + _o), (LAS unsigned*)(lds + (bufoff) + ldsw + _i * 8192), 16, 0, 0); } } \
        else { PG8_STAGE(bufoff, (const char*)(base) + (h) * hstepA, voffA); } } while (0)
#define PG8_LDA(dst, b, h) do { _Pragma("unroll") for (int m = 0; m < 4; ++m) _Pragma("unroll") for (int k = 0; k < 2; ++k) dst[m][k] = *(const LAS bf16x8*)(lds + PG8_SA(b, h) + aoff + m * 2048 + k * 1024); } while (0)
#define PG8_LDB(dst, b, h) do { _Pragma("unroll") for (int n = 0; n < 2; ++n) _Pragma("unroll") for (int k = 0; k < 2; ++k) dst[n][k] = *(const LAS bf16x8*)(lds + PG8_SB(b, h) + boff + n * 2048 + k * 1024); } while (0)
#define PG8_MMA(ai, bj, At, Bt) do { __builtin_amdgcn_s_setprio(1); _Pragma("unroll") for (int m = 0; m < 4; ++m) _Pragma("unroll") for (int n = 0; n < 2; ++n) _Pragma("unroll") for (int k = 0; k < 2; ++k) \
        acc[ai][bj][m][n] = __builtin_amdgcn_mfma_f32_16x16x32_bf16(Bt[n][k], At[m][k], acc[ai][bj][m][n], 0, 0, 0); __builtin_amdgcn_s_setprio(0); } while (0)
#define PG8_WAIT_V(n) asm volatile("s_waitcnt vmcnt(" #n ")" ::: "memory")
#define PG8_WAIT_L(n) asm volatile("s_waitcnt lgkmcnt(" #n ")" ::: "memory")
#define PG8_BAR __builtin_amdgcn_s_barrier()
#define PG8_SCHED __builtin_amdgcn_sched_barrier(0)
#define PG8_AKT(p1, p2, kt) ((DUAL && (kt) >= nt / 2) ? (p2) + (size_t)((kt) - nt / 2) * kstep : (p1) + (size_t)(kt) * kstep)
    Unit cur, nxt; int ui = 0;
    if (!S.next(0, cur)) return;
    f32x4 acc[2][2][4][2];
#pragma unroll
    for (int a = 0; a < 2; ++a)
#pragma unroll
        for (int b = 0; b < 2; ++b)
#pragma unroll
            for (int m = 0; m < 4; ++m)
#pragma unroll
                for (int n = 0; n < 2; ++n) acc[a][b][m][n] = (f32x4){0.f, 0.f, 0.f, 0.f};
    bf16x8 At[4][2], B0[2][2], B1[2][2];
    unsigned gA[2][2] = {{0u, 0u}, {0u, 0u}}, gN[2][2] = {{0u, 0u}, {0u, 0u}};
    const char* cA = S.aptr(cur); const char* cB = S.bptr(cur); const char* cA2 = cA; const char* nA2 = cA;
    if constexpr (DUAL) cA2 = S.aptr2(cur);
    if constexpr (Sched::GATHER) S.aoff(cur, tid, gA);
    PG8_STAGE(PG8_SB(0, 0), cB, voffB); PG8_STAGE(PG8_SB(0, 1), cB + hstep, voffB); PG8_STAGE_A(PG8_SA(0, 0), cA, 0, false); PG8_STAGE_A(PG8_SA(0, 1), cA, 1, false);
    if (wr == 1) PG8_BAR;
    PG8_WAIT_V(2); PG8_BAR;
    PG8_STAGE(PG8_SB(1, 0), cB + kstep, voffB); PG8_STAGE_A(PG8_SA(1, 0), cA + kstep, 0, false); PG8_STAGE(PG8_SB(1, 1), cB + hstep + kstep, voffB);
    PG8_WAIT_V(6); PG8_BAR;
    for (;;) {
        const bool has_next = S.next(ui + 1, nxt);
        const char* nA = has_next ? S.aptr(nxt) : cA; const char* nB = has_next ? S.bptr(nxt) : cB;
        if constexpr (DUAL) nA2 = has_next ? S.aptr2(nxt) : cA2;
        if constexpr (Sched::GATHER) { if (has_next) S.aoff(nxt, tid, gN); else {
#pragma unroll
            for (int h = 0; h < 2; ++h) { gN[h][0] = gA[h][0]; gN[h][1] = gA[h][1]; } } }
        for (int t = 0; t < nt; t += 2) {
            const bool last = (t == nt - 2);
            const char* a1 = PG8_AKT(cA, cA2, t + 1);
            const char* a2 = last ? nA : PG8_AKT(cA, cA2, t + 2); const char* b2 = last ? nB : cB + (size_t)(t + 2) * kstep;
            const char* a3 = last ? nA + kstep : PG8_AKT(cA, cA2, t + 3); const char* b3 = b2 + kstep;
            if constexpr (DUAL) { if (t == nt / 2) E.mid(acc, cur, wr, wc, fr, fq); }
            PG8_LDB(B0, 0, 0); PG8_LDB(B1, 0, 1); PG8_SCHED; PG8_LDA(At, 0, 0); PG8_STAGE_A(PG8_SA(1, 1), a1, 1, false);
            PG8_WAIT_V(8); PG8_WAIT_L(0); PG8_BAR; PG8_MMA(0, 0, At, B0); PG8_MMA(0, 1, At, B1); PG8_BAR; PG8_SCHED;
            PG8_LDA(At, 0, 1); PG8_STAGE(PG8_SB(0, 0), b2, voffB); PG8_STAGE(PG8_SB(0, 1), b2 + hstep, voffB); PG8_STAGE_A(PG8_SA(0, 0), a2, 0, last);
            PG8_WAIT_V(8); PG8_WAIT_L(0); PG8_BAR; PG8_MMA(1, 0, At, B0); PG8_MMA(1, 1, At, B1); PG8_BAR; PG8_SCHED;
            PG8_LDB(B0, 1, 0); PG8_LDB(B1, 1, 1); PG8_SCHED; PG8_LDA(At, 1, 0); PG8_STAGE_A(PG8_SA(0, 1), a2, 1, last);
            PG8_WAIT_V(8); PG8_WAIT_L(0); PG8_BAR; PG8_MMA(0, 0, At, B0); PG8_MMA(0, 1, At, B1); PG8_BAR; PG8_SCHED;
            PG8_LDA(At, 1, 1); PG8_STAGE(PG8_SB(1, 0), b3, voffB); PG8_STAGE(PG8_SB(1, 1), b3 + hstep, voffB); PG8_STAGE_A(PG8_SA(1, 0), a3, 0, last);
            PG8_WAIT_V(8); PG8_WAIT_L(0); PG8_BAR; PG8_MMA(1, 0, At, B0); PG8_MMA(1, 1, At, B1); PG8_BAR; PG8_SCHED;
        }
        if constexpr (ALIGN_EPI) { if (wr == 0) PG8_BAR; }
        E(acc, cur, wr, wc, fr, fq);
        if (!has_next) break;
#pragma unroll
        for (int a = 0; a < 2; ++a)
#pragma unroll
            for (int b = 0; b < 2; ++b)
#pragma unroll
                for (int m = 0; m < 4; ++m)
#pragma unroll
                    for (int n = 0; n < 2; ++n) acc[a][b][m][n] = (f32x4){0.f, 0.f, 0.f, 0.f};
        cur = nxt; cA = nA; cB = nB; ++ui; if constexpr (DUAL) cA2 = nA2;
        if constexpr (Sched::GATHER) {
#pragma unroll
            for (int h = 0; h < 2; ++h) { gA[h][0] = gN[h][0]; gA[h][1] = gN[h][1]; } }
        if constexpr (ALIGN_EPI) { if (wr == 1) PG8_BAR; }
    }
    PG8_WAIT_V(0);
    if constexpr (!ALIGN_EPI) { if (wr == 0) PG8_BAR; }
    PG8_BAR;
#undef PG8_AKT
#undef PG8_SA
#undef PG8_SB
#undef PG8_STAGE
#undef PG8_STAGE_A
#undef PG8_LDA
#undef PG8_LDB
#undef PG8_MMA
#undef PG8_WAIT_V
#undef PG8_WAIT_L
#undef PG8_BAR
#undef PG8_SCHED
}
}

struct Frame {
    LAS unsigned char* lds;
    gu32* ctl;
    int tid, lane, wave, G, vcu;
    const float* in[23]; float* out; unsigned char* ws;
};
#define IN_X 0
#define IN_C 1
#define IN_CTX 2
#define IN_CCTX 3
#define IN_WADA 4
#define IN_BADA 5
#define IN_N1W 6
#define IN_WIN 7
#define IN_BMG 8
#define IN_QNW 9
#define IN_KNW 10
#define IN_MHW 11
#define IN_WBM 12
#define IN_WBA 13
#define IN_WOUT 14
#define IN_N2W 15
#define IN_WRG 16
#define IN_BRG 17
#define IN_WRE 18
#define IN_BRE 19
#define IN_WEG 20
#define IN_WEU 21
#define IN_WED 22

__device__ __forceinline__ void p0_ada(Frame& F) {
    LAS float* sl = (LAS float*)F.lds;
    LAS float* red = sl + 17 * 1024;
    const float* cc = F.in[IN_C]; const float* cx = F.in[IN_CCTX];
    for (int i = F.tid; i < 17 * 1024; i += NTHREADS) { const int r = i >> 10, k = i & 1023; const float c = r < 16 ? cc[r * 1024 + k] : cx[k]; sl[i] = siluf_(c); }
    __syncthreads();
    const float* W = F.in[IN_WADA]; const float* bias = F.in[IN_BADA]; float* mod = (float*)(F.ws + WS_MOD);
    const int j = F.lane & 31, kk = F.lane >> 5;
    for (int cb = blockIdx.x; cb < 256; cb += F.G) {
        const int col0 = cb * 24;
        float acc[17];
#pragma unroll
        for (int r = 0; r < 17; ++r) acc[r] = 0.f;
        if (j < 24) {
#pragma unroll 4
            for (int it = 0; it < 64; ++it) { const int k = F.wave * 128 + it * 2 + kk; const float w = W[(size_t)k * NMOD + col0 + j];
#pragma unroll
                for (int r = 0; r < 17; ++r) acc[r] += sl[r * 1024 + k] * w; }
        }
#pragma unroll
        for (int r = 0; r < 17; ++r) acc[r] += __shfl_xor(acc[r], 32);
        if (F.lane < 32) {
#pragma unroll
            for (int r = 0; r < 17; ++r) red[(F.wave * 17 + r) * 32 + j] = acc[r]; }
        __syncthreads();
        if (F.tid < 17 * 24) { const int r = F.tid / 24, jj = F.tid % 24; float s = 0.f;
#pragma unroll
            for (int w = 0; w < 8; ++w) s += red[(w * 17 + r) * 32 + jj];
            mod[r * NMOD + col0 + jj] = s + bias[col0 + jj]; }
        __syncthreads();
    }
}
template <class DR>
__device__ __forceinline__ void transpose_item(const float* W, int K, int N, bf16_t* WT, const DR& destrow, LAS float* scr, int item, int lane, int ldw = 0, int koff = 0) {
    if (ldw == 0) ldw = K;
    const int nblk = N / 32, kb = item / nblk, nb = item % nblk, k0 = 64 * kb, n0 = 32 * nb;
#pragma unroll 8
    for (int i = 0; i < 32; ++i) { const int kk = 2 * i + (lane >> 5); scr[kk * 33 + (lane & 31)] = W[(size_t)(k0 + kk) * N + n0 + (lane & 31)]; }
    LDS_WAIT(); asm volatile("" ::: "memory");
    const int c = lane & 7;
#pragma unroll
    for (int j = 0; j < 4; ++j) { const int n = (lane >> 3) + 8 * j; const LAS float* s = scr + (8 * c) * 33 + n;
        u32x4 o; o.x = pk2(s[0 * 33], s[1 * 33]); o.y = pk2(s[2 * 33], s[3 * 33]); o.z = pk2(s[4 * 33], s[5 * 33]); o.w = pk2(s[6 * 33], s[7 * 33]);
        *(GAS u32x4*)(WT + (size_t)destrow(n0 + n) * ldw + koff + k0 + 8 * c) = o; }
    LDS_WAIT(); asm volatile("" ::: "memory");
}
struct DrIdent { int off; __device__ __forceinline__ int operator()(int n) const { return off + n; } };
__device__ __forceinline__ int qk_pos(int d) { const int half = d >> 6, dl = d & 63, n = dl >> 5, i = dl & 31; return 32 * (2 * half + (i >> 4)) + 8 * ((i >> 2) & 3) + 4 * n + (i & 3); }
struct DrWin { __device__ __forceinline__ int operator()(int n) const {
    if (n < 1024) return 2816 + n;
    if (n < 2048) return n - 1024;
    if (n < 3072) return 1024 + (n - 2048);
    if (n < 4096) return 3840 + (n - 3072);
    if (n < 4128) return 2560 + (n - 4096);
    if (n < 5152) { const int q = n - 4128; return 4864 + (q & ~127) + qk_pos(q & 127); }
    if (n < 5408) { const int q = n - 5152; return 2048 + (q & ~127) + qk_pos(q & 127); }
    if (n < 5664) return 2304 + (n - 5408);
    return 5888 + (n - 5664); } };
__device__ __forceinline__ void p0_prologue(Frame& F) {
    p0_ada(F);
    __syncthreads();
    LAS float* scr = (LAS float*)(F.lds + F.wave * 16384);
    const int gw = F.vcu * NWAVES + F.wave, NGW = F.G * NWAVES;
    constexpr int I_IN = 16 * (IN_W / 32), I_SQ = 16 * 32;
    bf16_t* win_t = (bf16_t*)(F.ws + WS_WIN);
    for (int it = gw; it < I_IN + 3 * I_SQ; it += NGW) {
        int r = it;
        if (r < I_IN) { transpose_item(F.in[IN_WIN], D, IN_W, win_t, DrWin{}, scr, r, F.lane); continue; } r -= I_IN;
        if (r < I_SQ) { transpose_item(F.in[IN_WBM], D, D, (bf16_t*)(F.ws + WS_WBM), DrIdent{0}, scr, r, F.lane, 2 * D, 0); continue; } r -= I_SQ;
        if (r < I_SQ) { transpose_item(F.in[IN_WBA], D, D, (bf16_t*)(F.ws + WS_WBM), DrIdent{0}, scr, r, F.lane, 2 * D, D); continue; } r -= I_SQ;
        transpose_item(F.in[IN_WOUT], D, D, (bf16_t*)(F.ws + WS_WO), DrIdent{0}, scr, r, F.lane);
    }
    { GAS u32x4* z = (GAS u32x4*)(win_t + (size_t)2592 * D); const int n16 = 224 * D * 2 / 16;
      for (int i = blockIdx.x * NTHREADS + F.tid; i < n16; i += F.G * NTHREADS) z[i] = (u32x4){0u, 0u, 0u, 0u}; }
    { bf16_t* wr = (bf16_t*)(F.ws + WS_WR); const float* wrg = F.in[IN_WRG]; const float* wre = F.in[IN_WRE];
      for (int i = blockIdx.x * NTHREADS + F.tid; i < 256 * D; i += F.G * NTHREADS) { const int o = i >> 10, k = i & 1023; const int oo = o < 36 ? o : ((o >= 64 && o < 100) ? o - 64 : -1);
          unsigned v = 0u; if (oo >= 0) { const float w = oo < 4 ? wrg[k * 4 + oo] : wre[k * 32 + oo - 4]; const unsigned hi = f2bf(w); v = o < 36 ? hi : f2bf(w - __builtin_bit_cast(float, hi << 16)); }
          wr[i] = (bf16_t)v; } }
    { float* tab = (float*)(F.ws + WS_ROPE);
      for (int i = blockIdx.x * NTHREADS + F.tid; i < 2048; i += F.G * NTHREADS) { const int pos = i >> 5, fi = i & 31;
          const float inv = powf(10000.0f, -(float)(2 * fi) / 64.0f); const float ang = (float)pos * inv; tab[i] = cosf(ang); tab[2048 + i] = sinf(ang); } }
}

__device__ __forceinline__ void p1_a0(Frame& F) {
    const int gw = F.vcu * NWAVES + F.wave, NGW = F.G * NWAVES;
    const float* mod = (const float*)(F.ws + WS_MOD); const float* n1w = F.in[IN_N1W]; bf16_t* A0 = (bf16_t*)(F.ws + WS_A0);
    for (int row = gw; row < T_ALL; row += NGW) {
        const float* src = row < T_LAT ? F.in[IN_X] + (size_t)row * D : F.in[IN_CTX] + (size_t)(row - T_LAT) * D;
        const int mr = row < T_LAT ? row / SEQ : 16;
        const GAS f32x4* xr = (const GAS f32x4*)src + F.lane;
        f32x4 v[4]; float s = 0.f;
#pragma unroll
        for (int j = 0; j < 4; ++j) { v[j] = xr[64 * j]; s += (v[j].x * v[j].x + v[j].y * v[j].y) + (v[j].z * v[j].z + v[j].w * v[j].w); }
        const float rinv = 1.0f / sqrtf(wave_sum(s) * (1.0f / D) + EPS);
        GAS u32x2* o8 = (GAS u32x2*)(A0 + (size_t)row * D) + F.lane;
#pragma unroll
        for (int j = 0; j < 4; ++j) { const int col = 256 * j + 4 * F.lane;
            const f32x4 w = *(const f32x4*)(n1w + col), sh = *(const f32x4*)(mod + mr * NMOD + col), sc = *(const f32x4*)(mod + mr * NMOD + D + col);
            const f32x4 y = (v[j] * rinv) * w * (sc + 1.0f) + sh;
            u32x2 o; o.x = pk2(y.x, y.y); o.y = pk2(y.z, y.w); o8[64 * j] = o; }
    }
}

struct InProjOrder { static constexpr bool GATHER = false; const char* A; const char* Bt; int G, c;
    __device__ __forceinline__ bool next(int i, pg8::Unit& u) const { const long L = (long)i * G + c; constexpr int NL = MT_LAT * NT_LAT, NC = MT_CTX * NT_CTX; if (L >= NL + NC) return false;
        if (L < NL) pg8::tile_of((int)L, MT_LAT, NT_LAT, u.pm, u.pn); else { const int q = (int)L - NL; u.pm = MT_LAT + q % MT_CTX; u.pn = q / MT_CTX; } u.x0 = 0; u.x1 = 0; return true; }
    __device__ __forceinline__ const char* aptr(const pg8::Unit& u) const { return A + (size_t)u.pm * (256 * D * 2); }
    __device__ __forceinline__ const char* bptr(const pg8::Unit& u) const { return Bt + (size_t)u.pn * (256 * D * 2); }
    __device__ __forceinline__ void aoff(const pg8::Unit&, int, unsigned (&)[2][2]) const {}
};
__device__ __forceinline__ int krow_of(int r0) { if (r0 < T_LAT) return (r0 / SEQ) * KVL + (r0 % SEQ); const int q = r0 - T_LAT; return (q / CTXL) * KVL + SEQ + (q % CTXL); }
struct EpiInProj { static constexpr bool PERM = true; unsigned char* ws; bf16_t* mg; const float* bgate; const float* qnw; const float* knw; LAS unsigned char* lds;
    __device__ __forceinline__ void operator()(const f32x4 (&acc)[2][2][4][2], const pg8::Unit& u, int wr, int wc, int fr, int fq) const {
        const int pn = u.pn; int r0 = u.pm * 256; bf16_t* base; int ldc = D, colt;
        if (pn == 10) {
            if (wc == 0) { float* g = (float*)(ws + WS_GATES); const f32x4 b0 = *(const f32x4*)(bgate + 8 * fq), b1 = *(const f32x4*)(bgate + 8 * fq + 4);
#pragma unroll
                for (int ai = 0; ai < 2; ++ai)
#pragma unroll
                    for (int m = 0; m < 4; ++m) { float* p = g + (size_t)(r0 + ai * 128 + wr * 64 + m * 16 + fr) * 32 + 8 * fq;
                        *(f32x4*)p = acc[ai][0][m][0] + b0; *(f32x4*)(p + 4) = acc[ai][0][m][1] + b1; } }
            return; }
        const bool isk = pn == 8, isq = pn >= 19 && pn < 23;
        const int t0 = u.pm < MT_LAT ? (r0 % SEQ) : -1;
        if (pn < 4) { base = (bf16_t*)(ws + WS_MK); colt = pn * 256; }
        else if (pn < 8) { base = (bf16_t*)(ws + WS_MV); colt = (pn - 4) * 256; }
        else if (pn < 10) { base = (bf16_t*)(ws + (pn == 8 ? WS_AK : WS_AV)); ldc = 256; colt = 0; r0 = krow_of(r0); }
        else if (pn < 15) { base = (bf16_t*)(ws + WS_MQ); colt = (pn - 11) * 256; }
        else if (pn < 19) { base = (bf16_t*)(ws + WS_OG); colt = (pn - 15) * 256; }
        else if (pn < 23) { base = (bf16_t*)(ws + WS_AQ); colt = (pn - 19) * 256; }
        else { base = mg; ldc = 2 * D; colt = (pn - 23) * 256; }
        const int row0 = r0 + wr * 64 + fr, col0 = colt + wc * 32 + 8 * fq;
        if (isk || isq) {
            LAS float* xs = (LAS float*)(lds + pg8::STAGE_BYTES);
#pragma unroll
            for (int ai = 0; ai < 2; ++ai)
#pragma unroll
                for (int m = 0; m < 4; ++m)
#pragma unroll
                    for (int bj = 0; bj < 2; ++bj) { const f32x4 a = acc[ai][bj][m][0], b = acc[ai][bj][m][1];
                        float ss = (a[0] * a[0] + a[1] * a[1]) + (a[2] * a[2] + a[3] * a[3]) + (b[0] * b[0] + b[1] * b[1]) + (b[2] * b[2] + b[3] * b[3]);
                        ss += __shfl_xor(ss, 16); ss += __shfl_xor(ss, 32);
                        if (fq == 0) xs[(bj * 256 + ai * 128 + wr * 64 + m * 16 + fr) * 4 + wc] = ss; }
            LDS_WAIT(); __builtin_amdgcn_s_barrier(); asm volatile("" ::: "memory");
            const float* nw = isk ? knw : qnw; const float* tab = (const float*)(ws + WS_ROPE);
            const int dlo = 64 * (wc >> 1) + 16 * (wc & 1) + 4 * fq;
            const f32x4 w0 = *(const f32x4*)(nw + dlo), w1 = *(const f32x4*)(nw + dlo + 32);
#pragma unroll
            for (int ai = 0; ai < 2; ++ai)
#pragma unroll
                for (int m = 0; m < 4; ++m) { const int rl = ai * 128 + wr * 64 + m * 16 + fr; bf16_t* rowp = base + (size_t)(row0 + ai * 128 + m * 16) * ldc + col0;
                    f32x4 cs = (f32x4){1.f, 1.f, 1.f, 1.f}, sn = (f32x4){0.f, 0.f, 0.f, 0.f};
                    if (t0 >= 0) { const int t = t0 + rl; const int pos = (wc >> 1) ? (t & 63) : (t >> 6); cs = *(const f32x4*)(tab + pos * 32 + 16 * (wc & 1) + 4 * fq); sn = *(const f32x4*)(tab + 2048 + pos * 32 + 16 * (wc & 1) + 4 * fq); }
#pragma unroll
                    for (int bj = 0; bj < 2; ++bj) { const f32x4 p4 = *(const LAS f32x4*)(xs + (bj * 256 + rl) * 4);
                        const float rinv = 1.0f / sqrtf(((p4.x + p4.y) + (p4.z + p4.w)) * (1.0f / 128.0f) + EPS);
                        const f32x4 x1 = (acc[ai][bj][m][0] * rinv) * w0, x2 = (acc[ai][bj][m][1] * rinv) * w1;
                        const f32x4 y1 = x1 * cs - x2 * sn, y2 = x2 * cs + x1 * sn;
                        u32x4 w; w.x = cvt_pk_bf16(y1[0], y1[1]); w.y = cvt_pk_bf16(y1[2], y1[3]); w.z = cvt_pk_bf16(y2[0], y2[1]); w.w = cvt_pk_bf16(y2[2], y2[3]);
                        *(u32x4*)(rowp + bj * 128) = w; } }
            return; }
#pragma unroll
        for (int ai = 0; ai < 2; ++ai)
#pragma unroll
            for (int m = 0; m < 4; ++m) { bf16_t* rowp = base + (size_t)(row0 + ai * 128 + m * 16) * ldc + col0;
#pragma unroll
                for (int bj = 0; bj < 2; ++bj) { const f32x4 v0 = acc[ai][bj][m][0], v1 = acc[ai][bj][m][1];
                    u32x4 w; w.x = cvt_pk_bf16(v0[0], v0[1]); w.y = cvt_pk_bf16(v0[2], v0[3]); w.z = cvt_pk_bf16(v1[0], v1[1]); w.w = cvt_pk_bf16(v1[2], v1[3]);
                    *(u32x4*)(rowp + bj * 128) = w; } }
    }
};


namespace ml {
typedef short v4i16_t __attribute__((ext_vector_type(4)));
constexpr int PQ = 272, PT = 144;
constexpr int QS = 0, KS = 16384, VS = 32768;
constexpr int HST = QS;
constexpr int CT = 49152;
constexpr int PP = CT + 128 * PQ;
constexpr int SC = PP + 64 * PT;
constexpr int T_A = 0, T_PM = 36 * 64, T_B = 2 * 36 * 64, T_MP = 3 * 36 * 64, T_DS = T_MP + 36, T_WO = T_DS + 36, T_BL = T_WO + 36, T_AM = T_BL + 36;
constexpr int S_RS0 = T_AM + 36 + 12, S_RS1 = S_RS0 + 64, S_QN = S_RS1 + 64, S_N = S_QN + 64;
constexpr int END = SC + (S_N + 128) * 4;
static_assert(END <= MISC_OFF && (S_RS0 % 4) == 0, "mLSTM LDS map");
constexpr float QSCALE = 0.08838834764831845f;

__device__ __forceinline__ int off_b(int row, int ch) { return 256 * row + 16 * (ch ^ (((row & 3) << 2) | ((row >> 2) & 3))); }
struct LaneAddr { int rbase, xm64, tb0, tb1, xc32; };
__device__ __forceinline__ LaneAddr lane_addr(int lane) {
    const int fr = lane & 15, fq = lane >> 4, mr = ((fr & 3) << 2) | ((fr >> 2) & 3); LaneAddr a;
    a.rbase = 256 * fr + 16 * (fq ^ (mr & 3)); a.xm64 = 64 * (mr >> 2);
    const int g = lane >> 4, q = (lane & 15) >> 2, p = lane & 3;
    a.tb0 = 256 * (8 * g + q) + 16 * (p >> 1) + 8 * (p & 1); a.tb1 = 256 * (8 * g + q + 4) + 16 * ((p >> 1) ^ 1) + 8 * (p & 1); a.xc32 = 32 * ((q << 1) | (g & 1));
    return a;
}
__device__ __forceinline__ bf16x8 rfrag(const LAS unsigned char* base, int rb, int s, const LaneAddr& A) { return *(const LAS bf16x8*)(base + (A.rbase + ((64 * s) ^ A.xm64)) + 4096 * rb); }
__device__ __forceinline__ bf16x8 tfrag(const LAS unsigned char* base, int c, int ks, const LaneAddr& A) {
    const int o = (32 * c) ^ A.xc32;
    const v4i16_t a = __builtin_amdgcn_ds_read_tr16_b64_v4i16((LAS v4i16_t*)(base + (A.tb0 + o) + 8192 * ks));
    const v4i16_t b = __builtin_amdgcn_ds_read_tr16_b64_v4i16((LAS v4i16_t*)(base + (A.tb1 + o) + 8192 * ks));
    return (bf16x8){a[0], a[1], a[2], a[3], b[0], b[1], b[2], b[3]};
}
__device__ __forceinline__ bf16x8 pfrag(const LAS unsigned char* base, int pitch, int tile, int ks, int lane) {
    return *(const LAS bf16x8*)(base + (16 * tile + (lane & 15)) * pitch + (32 * ks + 8 * (lane >> 4)) * 2);
}
__device__ __forceinline__ float logsig(float x) { return fminf(x, 0.f) - __logf(1.0f + __expf(-fabsf(x))); }
__device__ __forceinline__ unsigned mulpk(unsigned w, float a, float b) { return cvt_pk_bf16(bflo(w) * a, bfhi(w) * b); }

__device__ __forceinline__ void unit(Frame& F, int b, int h) {
    LAS unsigned char* L = F.lds; LAS float* sc = (LAS float*)(L + SC);
    const int tid = F.tid, lane = F.lane, w = F.wave;
    const bf16_t* MQ = (const bf16_t*)(F.ws + WS_MQ); const bf16_t* MK = (const bf16_t*)(F.ws + WS_MK); const bf16_t* MV = (const bf16_t*)(F.ws + WS_MV);
    const bf16_t* OG = (const bf16_t*)(F.ws + WS_OG); bf16_t* HT = (bf16_t*)(F.ws + WS_HTMP); bf16_t* AM = (bf16_t*)(F.ws + WS_MQ);
    const float* GT = (const float*)(F.ws + WS_GATES); const float* mhw = F.in[IN_MHW];
    const int lr = tid >> 3, seg = tid & 7;
    const int wo0 = off_b(lr, 2 * seg), wo1 = off_b(lr, 2 * seg + 1);
    LaneAddr LA = lane_addr(lane);
    for (int dir = 0; dir < 2; ++dir) {
#define ML_GROW(st, r) ((st) < 4 ? (T_LAT + b * CTXL + (dir == 0 ? (st) * 64 + (r) : (3 - (st)) * 64 + 63 - (r))) : (b * SEQ + (dir == 0 ? ((st) - 4) * 64 + (r) : (35 - (st)) * 64 + 63 - (r))))
        for (int st = w; st < 36; st += 8) {
            const float* gp = GT + (size_t)ML_GROW(st, lane) * 32 + dir * 16 + h; const float g_i = gp[0], g_f = gp[8];
            float bc = logsig(g_f);
#pragma unroll
            for (int o = 1; o < 64; o <<= 1) { const float t = __shfl_up(bc, o); if (lane >= o) bc += t; }
            const float a = g_i - bc;
            float pm = a;
#pragma unroll
            for (int o = 1; o < 64; o <<= 1) { const float t = __shfl_up(pm, o); if (lane >= o) pm = fmaxf(pm, t); }
            sc[T_A + st * 64 + lane] = a; sc[T_PM + st * 64 + lane] = pm; sc[T_B + st * 64 + lane] = bc;
            if (lane == 63) { sc[T_BL + st] = bc; sc[T_AM + st] = pm; }
        }
        f32x4 accC[8], accN = (f32x4){0.f, 0.f, 0.f, 0.f};
#pragma unroll
        for (int e = 0; e < 8; ++e) accC[e] = (f32x4){0.f, 0.f, 0.f, 0.f};
        for (int i = tid; i < 128 * PQ / 4; i += NTHREADS) ((LAS unsigned*)(L + CT))[i] = 0u;
        if (tid < 128) sc[S_N + tid] = 0.f;
        LDS_WAIT(); __syncthreads();
        if (tid == 0) { float m = -1e30f;
            for (int st = 0; st < 36; ++st) { const float bl = sc[T_BL + st], mx = fmaxf(m, sc[T_AM + st]); sc[T_MP + st] = m; sc[T_DS + st] = -mx; sc[T_WO + st] = __expf(m - mx); m = bl + mx; } }
        u32x4 rq0, rq1, rk0, rk1, rv0, rv1;
        rq0 = rq1 = rk0 = rk1 = rv0 = rv1 = (u32x4){0u, 0u, 0u, 0u};
#define ML_LOAD(st) do { const size_t go = (size_t)ML_GROW(st, lr) * D + h * 128 + seg * 16; \
            if ((st) >= 4) { rq0 = *(const GAS u32x4*)(MQ + go); rq1 = *(const GAS u32x4*)(MQ + go + 8); } \
            rk0 = *(const GAS u32x4*)(MK + go); rk1 = *(const GAS u32x4*)(MK + go + 8); rv0 = *(const GAS u32x4*)(MV + go); rv1 = *(const GAS u32x4*)(MV + go + 8); } while (0)
#define ML_WRITE(st) do { if ((st) >= 4) { *(LAS u32x4*)(L + QS + wo0) = rq0; *(LAS u32x4*)(L + QS + wo1) = rq1; } \
            *(LAS u32x4*)(L + KS + wo0) = rk0; *(LAS u32x4*)(L + KS + wo1) = rk1; *(LAS u32x4*)(L + VS + wo0) = rv0; *(LAS u32x4*)(L + VS + wo1) = rv1; } while (0)
        ML_LOAD(0);
        ML_WRITE(0);
        ML_LOAD(1);
#if defined(PROBE_SEL)
        volatile LAS unsigned long long* pts = (volatile LAS unsigned long long*)(F.lds + MISC_OFF + 4096 + 8 * 24);
        if (blockIdx.x == 0 && tid == 0) { pts[3] = 0; pts[4] = 0; pts[5] = 0; }
#endif
        for (int st = 0; st < 36; ++st) {
            const bool lat = st >= 4;
            const LAS float* ta = sc + T_A + st * 64; const LAS float* tpm = sc + T_PM + st * 64; const LAS float* tb = sc + T_B + st * 64;
            LDS_WAIT(); __syncthreads();
            asm volatile("" : "+v"(LA.rbase), "+v"(LA.xm64), "+v"(LA.tb0), "+v"(LA.tb1), "+v"(LA.xc32));
#if defined(PROBE_SEL)
            if (blockIdx.x == 0 && tid == 0) { const unsigned long long t = __builtin_amdgcn_s_memrealtime(); if (st > 0) pts[5] += t - pts[2]; pts[0] = t; }
#endif
            const float mprev = sc[T_MP + st], dsc = sc[T_DS + st], wold = sc[T_WO + st];
            f32x4 acch[4];
            const int si = w >> 1, eb = 4 * (w & 1);
            if (lat) {
                bf16x8 qf[4];
#pragma unroll
                for (int ks = 0; ks < 4; ++ks) qf[ks] = rfrag(L + QS, si, ks, LA);
                const int s_col = 16 * si + (lane & 15); const float Ms = fmaxf(mprev, tpm[s_col]);
                float psum = 0.f;
#pragma unroll
                for (int rr = 0; rr < 2; ++rr) { const int ri = 2 * (w & 1) + rr; f32x4 a4 = (f32x4){0.f, 0.f, 0.f, 0.f};
#pragma unroll
                    for (int ks = 0; ks < 4; ++ks) a4 = __builtin_amdgcn_mfma_f32_16x16x32_bf16(rfrag(L + KS, ri, ks, LA), qf[ks], a4, 0, 0, 0);
                    const int r0 = 16 * ri + 4 * (lane >> 4); const f32x4 av = *(const LAS f32x4*)(ta + r0); float p[4];
#pragma unroll
                    for (int j = 0; j < 4; ++j) { const int r = r0 + j; p[j] = (r <= s_col) ? a4[j] * QSCALE * __expf(av[j] - Ms) : 0.f; psum += p[j]; }
                    u32x2 pw; pw.x = cvt_pk_bf16(p[0], p[1]); pw.y = cvt_pk_bf16(p[2], p[3]);
                    *(LAS u32x2*)(L + PP + s_col * PT + r0 * 2) = pw; }
                psum += __shfl_xor(psum, 16); psum += __shfl_xor(psum, 32);
                if (lane < 16) sc[((w & 1) ? S_RS1 : S_RS0) + s_col] = psum;
                { const u32x4 q0 = *(const LAS u32x4*)(L + QS + wo0), q1 = *(const LAS u32x4*)(L + QS + wo1);
                  const LAS f32x4* nv = (const LAS f32x4*)(sc + S_N + seg * 16); const f32x4 n0 = nv[0], n1 = nv[1], n2 = nv[2], n3 = nv[3];
                  float d = bflo(q0.x) * n0.x + bfhi(q0.x) * n0.y + bflo(q0.y) * n0.z + bfhi(q0.y) * n0.w + bflo(q0.z) * n1.x + bfhi(q0.z) * n1.y + bflo(q0.w) * n1.z + bfhi(q0.w) * n1.w
                          + bflo(q1.x) * n2.x + bfhi(q1.x) * n2.y + bflo(q1.y) * n2.z + bfhi(q1.y) * n2.w + bflo(q1.z) * n3.x + bfhi(q1.z) * n3.y + bflo(q1.w) * n3.z + bfhi(q1.w) * n3.w;
                  d += __shfl_xor(d, 1); d += __shfl_xor(d, 2); d += __shfl_xor(d, 4);
                  if (seg == 0) sc[S_QN + lr] = d; }
#pragma unroll
                for (int e = 0; e < 4; ++e) { acch[e] = (f32x4){0.f, 0.f, 0.f, 0.f};
#pragma unroll
                    for (int ks = 0; ks < 4; ++ks) acch[e] = __builtin_amdgcn_mfma_f32_16x16x32_bf16(pfrag(L + CT, PQ, eb + e, ks, lane), qf[ks], acch[e], 0, 0, 0); }
            }
            LDS_WAIT(); __syncthreads();
#if defined(PROBE_SEL)
            if (blockIdx.x == 0 && tid == 0) { const unsigned long long t = __builtin_amdgcn_s_memrealtime(); pts[3] += t - pts[0]; pts[1] = t; }
#endif
            {
                bf16x8 ka0 = tfrag(L + KS, w, 0, LA), ka1 = tfrag(L + KS, w, 1, LA);
                {
                    const LAS f32x4* ap = (const LAS f32x4*)(ta + 8 * (lane >> 4)); const f32x4 a0 = ap[0], a1 = ap[1], a2 = ap[8], a3 = ap[9];
                    u32x4 k0 = __builtin_bit_cast(u32x4, ka0), k1 = __builtin_bit_cast(u32x4, ka1);
                    k0.x = mulpk(k0.x, __expf(a0.x + dsc), __expf(a0.y + dsc)); k0.y = mulpk(k0.y, __expf(a0.z + dsc), __expf(a0.w + dsc)); k0.z = mulpk(k0.z, __expf(a1.x + dsc), __expf(a1.y + dsc)); k0.w = mulpk(k0.w, __expf(a1.z + dsc), __expf(a1.w + dsc));
                    k1.x = mulpk(k1.x, __expf(a2.x + dsc), __expf(a2.y + dsc)); k1.y = mulpk(k1.y, __expf(a2.z + dsc), __expf(a2.w + dsc)); k1.z = mulpk(k1.z, __expf(a3.x + dsc), __expf(a3.y + dsc)); k1.w = mulpk(k1.w, __expf(a3.z + dsc), __expf(a3.w + dsc));
                    ka0 = __builtin_bit_cast(bf16x8, k0); ka1 = __builtin_bit_cast(bf16x8, k1); }
#pragma unroll
                for (int e = 0; e < 8; ++e) { accC[e] = accC[e] * wold;
                    accC[e] = __builtin_amdgcn_mfma_f32_16x16x32_bf16(ka0, tfrag(L + VS, e, 0, LA), accC[e], 0, 0, 0);
                    accC[e] = __builtin_amdgcn_mfma_f32_16x16x32_bf16(ka1, tfrag(L + VS, e, 1, LA), accC[e], 0, 0, 0);
                    u32x2 cw; cw.x = cvt_pk_bf16(accC[e][0], accC[e][1]); cw.y = cvt_pk_bf16(accC[e][2], accC[e][3]);
                    *(LAS u32x2*)(L + CT + (16 * e + (lane & 15)) * PQ + (16 * w + 4 * (lane >> 4)) * 2) = cw; }
                { const unsigned one2 = ((lane & 15) == 0) ? 0x3f803f80u : 0u; const u32x4 ob = (u32x4){one2, one2, one2, one2};
                  accN = accN * wold;
                  accN = __builtin_amdgcn_mfma_f32_16x16x32_bf16(ka0, __builtin_bit_cast(bf16x8, ob), accN, 0, 0, 0);
                  accN = __builtin_amdgcn_mfma_f32_16x16x32_bf16(ka1, __builtin_bit_cast(bf16x8, ob), accN, 0, 0, 0);
                  if ((lane & 15) == 0) *(LAS f32x4*)(sc + S_N + 16 * w + 4 * (lane >> 4)) = accN; }
            }
            if (lat) {
                const int s = 16 * si + (lane & 15);
                const float M = fmaxf(mprev, tpm[s]); const float rwi = QSCALE * __expf(mprev - M);
                const float den = rwi * sc[S_QN + s] + sc[S_RS0 + s] + sc[S_RS1 + s]; const float rden = 1.0f / fmaxf(fabsf(den), __expf(-(tb[s] + M)));
                const bf16x8 pf0 = pfrag(L + PP, PT, si, 0, lane), pf1 = pfrag(L + PP, PT, si, 1, lane);
                const int hrow = 256 * s, hmask = ((s & 3) << 2) | ((s >> 2) & 3), g = lane >> 4;
#pragma unroll
                for (int e = 0; e < 4; ++e) {
                    acch[e] = acch[e] * rwi;
                    acch[e] = __builtin_amdgcn_mfma_f32_16x16x32_bf16(tfrag(L + VS, eb + e, 0, LA), pf0, acch[e], 0, 0, 0);
                    acch[e] = __builtin_amdgcn_mfma_f32_16x16x32_bf16(tfrag(L + VS, eb + e, 1, LA), pf1, acch[e], 0, 0, 0);
                    const f32x4 hv = acch[e] * rden;
                    u32x2 hw; hw.x = cvt_pk_bf16(hv[0], hv[1]); hw.y = cvt_pk_bf16(hv[2], hv[3]);
                    *(LAS u32x2*)(L + HST + hrow + 16 * ((2 * (eb + e) + (g >> 1)) ^ hmask) + 8 * (g & 1)) = hw; }
            }
            LDS_WAIT(); __syncthreads();
#if defined(PROBE_SEL)
            if (blockIdx.x == 0 && tid == 0) { const unsigned long long t = __builtin_amdgcn_s_memrealtime(); pts[4] += t - pts[1]; pts[2] = t; }
#endif
            {
                const size_t go = (size_t)ML_GROW(st, lr) * D + h * 128 + seg * 16;
                u32x4 h0 = (u32x4){0u, 0u, 0u, 0u}, h1 = h0;
                if (lat) { h0 = *(const LAS u32x4*)(L + HST + wo0); h1 = *(const LAS u32x4*)(L + HST + wo1); }
                if (st + 1 < 36) ML_WRITE(st + 1);
                asm volatile("" ::: "memory");
                if (lat) {
                    if (dir == 0) { *(GAS u32x4*)(HT + go) = h0; *(GAS u32x4*)(HT + go + 8) = h1; }
                    else {
                        const u32x4 f0 = *(const GAS u32x4*)(HT + go), f1 = *(const GAS u32x4*)(HT + go + 8), g0 = *(const GAS u32x4*)(OG + go), g1 = *(const GAS u32x4*)(OG + go + 8);
                        const unsigned hw[8] = {h0.x, h0.y, h0.z, h0.w, h1.x, h1.y, h1.z, h1.w}, fw[8] = {f0.x, f0.y, f0.z, f0.w, f1.x, f1.y, f1.z, f1.w}, gw[8] = {g0.x, g0.y, g0.z, g0.w, g1.x, g1.y, g1.z, g1.w};
                        float x[16]; float ss = 0.f;
#pragma unroll
                        for (int j = 0; j < 8; ++j) { x[2 * j] = bflo(hw[j]) + bflo(fw[j]); x[2 * j + 1] = bfhi(hw[j]) + bfhi(fw[j]); ss += x[2 * j] * x[2 * j] + x[2 * j + 1] * x[2 * j + 1]; }
                        ss += __shfl_xor(ss, 1); ss += __shfl_xor(ss, 2); ss += __shfl_xor(ss, 4);
                        const float rinv = 1.0f / sqrtf(ss * (1.0f / 128.0f) + EPS);
                        const float* mw = mhw + h * 128 + seg * 16; unsigned ow[8];
#pragma unroll
                        for (int j = 0; j < 8; ++j) { const float y0 = (x[2 * j] * rinv) * mw[2 * j] * sigmoidf_(bflo(gw[j])), y1 = (x[2 * j + 1] * rinv) * mw[2 * j + 1] * sigmoidf_(bfhi(gw[j])); ow[j] = cvt_pk_bf16(y0, y1); }
                        *(GAS u32x4*)(AM + go) = (u32x4){ow[0], ow[1], ow[2], ow[3]}; *(GAS u32x4*)(AM + go + 8) = (u32x4){ow[4], ow[5], ow[6], ow[7]};
                    }
                }
                asm volatile("" ::: "memory");
                if (st + 2 < 36) ML_LOAD(st + 2);
            }
        }
#if defined(PROBE_SEL)
        if (blockIdx.x == 0 && tid == 0) { volatile LAS unsigned long long* ts = (volatile LAS unsigned long long*)(F.lds + MISC_OFF + 4096); ts[14 + 3 * dir] = pts[3]; ts[15 + 3 * dir] = pts[4]; ts[16 + 3 * dir] = pts[5]; }
#endif
        VM_WAIT(); __syncthreads();
#undef ML_LOAD
#undef ML_WRITE
#undef ML_GROW
    }
}
}

namespace at {
constexpr int QBLK = 32, KVBLK = 64, LDQ = D, LDK = 256, LDO = D;
constexpr float SCALE = 0.088388347648318440f;
constexpr float THR = 8.f;
constexpr size_t SHM_V = KVBLK * 128 * 2, SHM_K = KVBLK * 128 * 2, SHM_ATTN = 2 * SHM_V + 2 * SHM_K + NWAVES * 64 * 4;
#define KSWZ(row, colB) ((row) * 256 + ((colB) ^ (((row) & 7) << 4)))
#define SBAR() __builtin_amdgcn_sched_barrier(0)
__device__ __forceinline__ int crow(int r, int hi) { return (r & 3) + 8 * (r >> 2) + 4 * hi; }
__device__ __forceinline__ void partialSM(f32x16& p0, f32x16& p1, float& m_reg, float& mn, float& alpha) {
  constexpr float C = SCALE * 1.4426950408889634f;
  float pmax = p0[0];
#pragma unroll
  for (int r = 1; r < 16; ++r) pmax = fmaxf(pmax, p0[r]);
#pragma unroll
  for (int r = 0; r < 16; ++r) pmax = fmaxf(pmax, p1[r]);
  { auto rr = __builtin_amdgcn_permlane32_swap(__float_as_uint(pmax), __float_as_uint(pmax), false, false);
    pmax = fmaxf(__uint_as_float(rr[0]), __uint_as_float(rr[1])); }
  if (__builtin_expect(__all(pmax - m_reg <= THR / SCALE), 1)) { mn = m_reg; alpha = 1.f; }
  else { mn = fmaxf(m_reg, pmax); alpha = __builtin_amdgcn_exp2f((m_reg - mn) * C); m_reg = mn; }
  float mnC = -mn * C;
#pragma unroll
  for (int r = 0; r < 16; ++r) p0[r] = fmaf(p0[r], C, mnC);
#pragma unroll
  for (int r = 0; r < 16; ++r) p1[r] = fmaf(p1[r], C, mnC);
#pragma unroll
  for (int r = 0; r < 16; ++r) p0[r] = __builtin_amdgcn_exp2f(p0[r]);
}
__device__ __forceinline__ void finishSM(f32x16& p0, f32x16& p1, float alpha, float& l_reg, bf16x8& pa0, bf16x8& pa1, bf16x8& pa2, bf16x8& pa3) {
#pragma unroll
  for (int r = 0; r < 16; ++r) p1[r] = __builtin_amdgcn_exp2f(p1[r]);
  float ps = 0;
#pragma unroll
  for (int r = 0; r < 16; ++r) ps += p0[r];
#pragma unroll
  for (int r = 0; r < 16; ++r) ps += p1[r];
  { auto rr = __builtin_amdgcn_permlane32_swap(__float_as_uint(ps), __float_as_uint(ps), false, false);
    ps = __uint_as_float(rr[0]) + __uint_as_float(rr[1]); }
  l_reg = l_reg * alpha + ps;
#define PK4(P, BASE, OUT) do { unsigned a0 = cvt_pk_bf16(P[BASE + 0], P[BASE + 1]), a1 = cvt_pk_bf16(P[BASE + 2], P[BASE + 3]);   \
    unsigned b0 = cvt_pk_bf16(P[BASE + 4], P[BASE + 5]), b1 = cvt_pk_bf16(P[BASE + 6], P[BASE + 7]);                              \
    auto r0 = __builtin_amdgcn_permlane32_swap(a0, b0, false, false); auto r1 = __builtin_amdgcn_permlane32_swap(a1, b1, false, false); \
    u32x4 w = {r0[0], r1[0], r0[1], r1[1]}; OUT = *reinterpret_cast<bf16x8*>(&w); } while (0)
  PK4(p0, 0, pa0); PK4(p0, 8, pa1); PK4(p1, 0, pa2); PK4(p1, 8, pa3);
#undef PK4
}
__device__ __forceinline__ void qkt(f32x16& p0, f32x16& p1, const char* Ks, const bf16x8* qr, int r32, int hi) {
  p0 = f32x16{}; p1 = f32x16{};
#pragma unroll
  for (int d0 = 0; d0 < 8; ++d0) { int cb = (d0 * 16 + hi * 8) * 2;
    bf16x8 b0 = *reinterpret_cast<const bf16x8*>(Ks + KSWZ(r32, cb));
    bf16x8 b1 = *reinterpret_cast<const bf16x8*>(Ks + KSWZ(32 + r32, cb));
    p0 = __builtin_amdgcn_mfma_f32_32x32x16_bf16(b0, qr[d0], p0, 0, 0, 0);
    p1 = __builtin_amdgcn_mfma_f32_32x32x16_bf16(b1, qr[d0], p1, 0, 0, 0); }
}
__device__ __forceinline__ int v_st(int k, int c) { const int kk = (k & ~0xC) | ((k & 4) << 1) | ((k & 8) >> 1); return ((kk >> 3) * 4 + (c >> 5)) * 512 + ((kk & 7) * 32 + (c & 31)) * 2; }
__device__ __forceinline__ int v_rd_base(int lane) { return ((lane & 3) << 3) | (((lane >> 2) & 3) << 6) | (((lane >> 4) & 1) << 5) | (((lane >> 5) & 1) << 8); }
constexpr int v_rd_off(int d0, int ks, int half) { return d0 * 512 + ks * 4096 + half * 2048; }
template <int OFF> __device__ __forceinline__ s16x4 tr_read(int vb) {
  s16x4 r; asm volatile("ds_read_b64_tr_b16 %0, %1 offset:%2" : "=&v"(r) : "v"(vb), "i"(OFF) : "memory"); return r;
}
template <int D0> __device__ __forceinline__ void pv_one(f32x16& od, int vb, bf16x8 pa0, bf16x8 pa1, bf16x8 pa2, bf16x8 pa3) {
  const s16x4 l0 = tr_read<v_rd_off(D0, 0, 0)>(vb), h0 = tr_read<v_rd_off(D0, 0, 1)>(vb), l1 = tr_read<v_rd_off(D0, 1, 0)>(vb), h1 = tr_read<v_rd_off(D0, 1, 1)>(vb);
  const s16x4 l2 = tr_read<v_rd_off(D0, 2, 0)>(vb), h2 = tr_read<v_rd_off(D0, 2, 1)>(vb), l3 = tr_read<v_rd_off(D0, 3, 0)>(vb), h3 = tr_read<v_rd_off(D0, 3, 1)>(vb);
  asm volatile("s_waitcnt lgkmcnt(0)" ::: "memory"); SBAR();
#define PK(L, H) (bf16x8){L[0], L[1], L[2], L[3], H[0], H[1], H[2], H[3]}
  od = __builtin_amdgcn_mfma_f32_32x32x16_bf16(pa0, PK(l0, h0), od, 0, 0, 0);
  od = __builtin_amdgcn_mfma_f32_32x32x16_bf16(pa1, PK(l1, h1), od, 0, 0, 0);
  od = __builtin_amdgcn_mfma_f32_32x32x16_bf16(pa2, PK(l2, h2), od, 0, 0, 0);
  od = __builtin_amdgcn_mfma_f32_32x32x16_bf16(pa3, PK(l3, h3), od, 0, 0, 0);
#undef PK
}
__device__ __forceinline__ void pv_d0(f32x16* o, int vb, bf16x8 pa0, bf16x8 pa1, bf16x8 pa2, bf16x8 pa3) {
  pv_one<0>(o[0], vb, pa0, pa1, pa2, pa3); pv_one<1>(o[1], vb, pa0, pa1, pa2, pa3); pv_one<2>(o[2], vb, pa0, pa1, pa2, pa3); pv_one<3>(o[3], vb, pa0, pa1, pa2, pa3);
}
__device__ __forceinline__ void body(const bf16_t* Qb, const bf16_t* __restrict__ Kh, const bf16_t* __restrict__ Vh, bf16_t* Ob, int seq, char* lds) {
  const int tid = threadIdx.x, wid = tid >> 6, lane = tid & 63, r32 = lane & 31, hi = lane >> 5;
  char* V_lds = lds; char* K_lds = lds + 2 * SHM_V;
  float* ws = (float*)(lds + 2 * SHM_V + 2 * SHM_K) + wid * 64; float* li_l = ws; float* al_l = ws + 32;
  float m_reg = -1e30f, l_reg = 0; f32x16 o[4] = {}; bf16x8 qr[8];
  const bf16_t* Qw = Qb + (long)(wid * QBLK + r32) * LDQ + hi * 8;
#pragma unroll
  for (int d0 = 0; d0 < 8; ++d0) qr[d0] = *reinterpret_cast<const bf16x8*>(Qw + d0 * 16);
  const int sr = tid >> 4, sc = (tid & 15) * 8, vst0 = v_st(sr, sc), vst1 = v_st(32 + sr, sc);
  const int vb0 = (int)(uintptr_t)V_lds + v_rd_base(lane);
  struct { bf16x8 vs0, vs1, ks0, ks1; } sr_[2];
#define SLOAD(i, k0) do { sr_[i].vs0 = *reinterpret_cast<const bf16x8*>(&Vh[(long)((k0) + sr) * LDK + sc]); sr_[i].vs1 = *reinterpret_cast<const bf16x8*>(&Vh[(long)((k0) + 32 + sr) * LDK + sc]); \
    sr_[i].ks0 = *reinterpret_cast<const bf16x8*>(&Kh[(long)((k0) + sr) * LDK + sc]); sr_[i].ks1 = *reinterpret_cast<const bf16x8*>(&Kh[(long)((k0) + 32 + sr) * LDK + sc]); } while (0)
#define SWRITE(b, i) do { *(bf16x8*)(V_lds + (b) * SHM_V + vst0) = sr_[i].vs0;          \
    *(bf16x8*)(V_lds + (b) * SHM_V + vst1) = sr_[i].vs1; int kc = sc * 2;               \
    *(bf16x8*)(K_lds + (b) * SHM_K + KSWZ(sr, kc)) = sr_[i].ks0;                       \
    *(bf16x8*)(K_lds + (b) * SHM_K + KSWZ(32 + sr, kc)) = sr_[i].ks1; } while (0)
#define SWAIT() asm volatile("s_waitcnt vmcnt(4)" ::: "memory")
#define RESC(a) do { if (__any((a) < 1.f)) { if (hi == 0) al_l[r32] = (a); asm volatile("s_waitcnt lgkmcnt(0)" ::: "memory"); \
    _Pragma("unroll") for (int d = 0; d < 4; ++d) _Pragma("unroll") for (int r = 0; r < 16; ++r) o[d][r] *= al_l[crow(r, hi)]; } } while (0)
  f32x16 pA0, pA1, pB0, pB1; float mnA, mnB, alA, alB; bf16x8 pa0, pa1, pa2, pa3; const int NT = seq / KVBLK;
  constexpr int SE = 0, SO = 1;
  SLOAD(SE, 0); asm volatile("s_waitcnt vmcnt(0)" ::: "memory"); SWRITE(0, SE); __syncthreads();
  qkt(pA0, pA1, K_lds, qr, r32, hi); partialSM(pA0, pA1, m_reg, mnA, alA);
  SLOAD(SO, KVBLK); if (2 < NT) SLOAD(SE, 2 * KVBLK);
  SWAIT(); SWRITE(1, SO); __syncthreads();
  for (int j = 1; j + 1 < NT; j += 2) {
    SBAR(); qkt(pB0, pB1, K_lds + SHM_K, qr, r32, hi);
    finishSM(pA0, pA1, alA, l_reg, pa0, pa1, pa2, pa3); SBAR();
    SLOAD(SO, (j + 2) * KVBLK); SBAR();
    pv_d0(o, vb0, pa0, pa1, pa2, pa3); partialSM(pB0, pB1, m_reg, mnB, alB);
    __syncthreads(); SWAIT(); SWRITE(0, SE);
    RESC(alB); __syncthreads();
    SBAR(); qkt(pA0, pA1, K_lds, qr, r32, hi);
    finishSM(pB0, pB1, alB, l_reg, pa0, pa1, pa2, pa3); SBAR();
    if (j + 3 < NT) SLOAD(SE, (j + 3) * KVBLK); SBAR();
    pv_d0(o, vb0 + (int)SHM_V, pa0, pa1, pa2, pa3); partialSM(pA0, pA1, m_reg, mnA, alA);
    __syncthreads(); SWAIT(); SWRITE(1, SO);
    RESC(alA); __syncthreads();
  }
  SBAR(); qkt(pB0, pB1, K_lds + SHM_K, qr, r32, hi);
  finishSM(pA0, pA1, alA, l_reg, pa0, pa1, pa2, pa3); SBAR();
  pv_d0(o, vb0, pa0, pa1, pa2, pa3); partialSM(pB0, pB1, m_reg, mnB, alB);
  __syncthreads(); RESC(alB);
  finishSM(pB0, pB1, alB, l_reg, pa0, pa1, pa2, pa3); SBAR();
  pv_d0(o, vb0 + (int)SHM_V, pa0, pa1, pa2, pa3);
  if (hi == 0) li_l[r32] = l_reg; asm volatile("s_waitcnt lgkmcnt(0)" ::: "memory");
  float rli[16];
#pragma unroll
  for (int r = 0; r < 16; ++r) rli[r] = __builtin_amdgcn_rcpf(li_l[crow(r, hi)]);
  bf16_t* Ow = Ob + (long)(wid * QBLK) * LDO;
#pragma unroll
  for (int r = 0; r < 16; ++r) { int orow = crow(r, hi);
#pragma unroll
    for (int d0 = 0; d0 < 4; ++d0) Ow[(long)orow * LDO + d0 * 32 + r32] = (bf16_t)f2bf(o[d0][r] * rli[r]); }
  __syncthreads();
#undef SLOAD
#undef SWRITE
#undef SWAIT
#undef RESC
}
#undef KSWZ
#undef SBAR
}

__device__ __forceinline__ void p4_mixers(Frame& F) {
    for (int u = blockIdx.x; u < NB * 8; u += F.G) ml::unit(F, u >> 3, u & 7);
#if defined(PROBE_SEL)
    if (blockIdx.x == 0 && F.tid == 0) ((volatile LAS unsigned long long*)(F.lds + MISC_OFF + 4096))[13] = __builtin_amdgcn_s_memrealtime();
#endif
    volatile LAS int* qslot = (volatile LAS int*)(F.lds + MISC_OFF + 64);
    bf16_t* AQ = (bf16_t*)(F.ws + WS_AQ); const bf16_t* AK = (const bf16_t*)(F.ws + WS_AK); const bf16_t* AV = (const bf16_t*)(F.ws + WS_AV);
    for (;;) {
        if (F.tid == 0) *qslot = (int)__hip_atomic_fetch_add((unsigned*)(F.ctl + CW_ATTQ), 1u, RLX_AGENT);
        __syncthreads();
        const int idx = *qslot;
        __syncthreads();
        if (idx >= NB * 8 * 8) break;
        const int b = idx >> 6, kvh = (idx >> 5) & 1, g = (idx >> 3) & 3, qb = idx & 7, head = kvh * 4 + g;
        bf16_t* Q = AQ + (size_t)(b * SEQ + qb * 256) * D + head * 128;
        const bf16_t* K = AK + (size_t)(b * KVL) * 256 + kvh * 128; const bf16_t* V = AV + (size_t)(b * KVL) * 256 + kvh * 128;
        at::body(Q, K, V, Q, KVL, (char*)F.lds);
    }
}

struct RectOrder { static constexpr bool GATHER = false; const char* A; const char* A2; const char* Bt; int nM, nN, K, lda, G, c;
    __device__ __forceinline__ bool next(int i, pg8::Unit& u) const { const long L = (long)i * G + c; if (L >= nM * nN) return false; pg8::tile_of((int)L, nM, nN, u.pm, u.pn); u.x0 = 0; u.x1 = 0; return true; }
    __device__ __forceinline__ const char* aptr(const pg8::Unit& u) const { return A + (size_t)u.pm * 256 * lda * 2; }
    __device__ __forceinline__ const char* aptr2(const pg8::Unit& u) const { return A2 + (size_t)u.pm * 256 * lda * 2; }
    __device__ __forceinline__ const char* bptr(const pg8::Unit& u) const { return Bt + (size_t)u.pn * 256 * K * 2; }
    __device__ __forceinline__ void aoff(const pg8::Unit&, int, unsigned (&)[2][2]) const {}
};
struct EpiMerge { static constexpr bool PERM = true; const bf16_t* mg; bf16_t* Z;
    __device__ __forceinline__ void mid(f32x4 (&acc)[2][2][4][2], const pg8::Unit& u, int wr, int wc, int fr, int fq) const {
        const int row0 = u.pm * 256 + wr * 64 + fr, col0 = u.pn * 256 + wc * 32 + 8 * fq;
#pragma unroll
        for (int ai = 0; ai < 2; ++ai)
#pragma unroll
            for (int m = 0; m < 4; ++m) { const size_t row = (size_t)(row0 + ai * 128 + m * 16);
#pragma unroll
                for (int bj = 0; bj < 2; ++bj) { const int col = col0 + bj * 128;
                    const u32x4 g0 = *(const GAS u32x4*)(mg + row * (2 * D) + col), g1 = *(const GAS u32x4*)(mg + row * (2 * D) + D + col);
                    const unsigned a[4] = {g0.x, g0.y, g0.z, g0.w}, b[4] = {g1.x, g1.y, g1.z, g1.w};
#pragma unroll
                    for (int j = 0; j < 4; ++j) { const float r0 = (1.0f + __expf(-bflo(b[j]))) / (1.0f + __expf(-bflo(a[j]))), r1 = (1.0f + __expf(-bfhi(b[j]))) / (1.0f + __expf(-bfhi(a[j])));
                        acc[ai][bj][m][j >> 1][(2 * j) & 3] *= r0; acc[ai][bj][m][j >> 1][(2 * j + 1) & 3] *= r1; } }
                asm volatile("" ::: "memory"); }
    }
    __device__ __forceinline__ void operator()(const f32x4 (&acc)[2][2][4][2], const pg8::Unit& u, int wr, int wc, int fr, int fq) const {
        const int row0 = u.pm * 256 + wr * 64 + fr, col0 = u.pn * 256 + wc * 32 + 8 * fq;
#pragma unroll
        for (int ai = 0; ai < 2; ++ai)
#pragma unroll
            for (int m = 0; m < 4; ++m) { const size_t row = (size_t)(row0 + ai * 128 + m * 16);
#pragma unroll
                for (int bj = 0; bj < 2; ++bj) { const int col = col0 + bj * 128;
                    const u32x4 gw = *(const GAS u32x4*)(mg + row * (2 * D) + D + col);
                    const f32x4 v0 = acc[ai][bj][m][0], v1 = acc[ai][bj][m][1];
                    u32x4 w; w.x = cvt_pk_bf16(sigmoidf_(bflo(gw.x)) * v0[0], sigmoidf_(bfhi(gw.x)) * v0[1]); w.y = cvt_pk_bf16(sigmoidf_(bflo(gw.y)) * v0[2], sigmoidf_(bfhi(gw.y)) * v0[3]);
                    w.z = cvt_pk_bf16(sigmoidf_(bflo(gw.z)) * v1[0], sigmoidf_(bfhi(gw.z)) * v1[1]); w.w = cvt_pk_bf16(sigmoidf_(bflo(gw.w)) * v1[2], sigmoidf_(bfhi(gw.w)) * v1[3]);
                    *(GAS u32x4*)(Z + row * D + col) = w; }
                asm volatile("" ::: "memory"); }
    }
};
struct EpiOut { static constexpr bool PERM = false; const float* x; const float* mod; float* out;
    __device__ __forceinline__ void operator()(const f32x4 (&acc)[2][2][4][2], const pg8::Unit& u, int wr, int wc, int fr, int fq) const {
        const int row0 = u.pm * 256 + wr * 64 + fr, col0 = u.pn * 256 + wc * 32 + 4 * fq; const float* g1 = mod + (size_t)((u.pm * 256) / SEQ) * NMOD + 2 * D;
#pragma unroll
        for (int ai = 0; ai < 2; ++ai)
#pragma unroll
            for (int m = 0; m < 4; ++m) { const size_t ro = (size_t)(row0 + ai * 128 + m * 16) * D;
#pragma unroll
                for (int bj = 0; bj < 2; ++bj)
#pragma unroll
                    for (int n = 0; n < 2; ++n) { const int col = col0 + bj * 128 + n * 16;
                        const f32x4 xv = *(const GAS f32x4*)(x + ro + col), gv = *(const f32x4*)(g1 + col);
                        *(GAS f32x4*)(out + ro + col) = xv + gv * acc[ai][bj][m][n]; }
                asm volatile("" ::: "memory"); }
    }
};

struct DrGU { int up; __device__ __forceinline__ int operator()(int j) const { return 256 * (j >> 7) + 128 * ((j >> 6) & 1) + 32 * ((j >> 4) & 3) + 8 * ((j >> 2) & 3) + 4 * up + (j & 3); } };
__device__ __forceinline__ void p6_fl(Frame& F) {
    const int gw = F.vcu * NWAVES + F.wave, NGW = F.G * NWAVES;
    {
        LAS float* scr = (LAS float*)(F.lds + F.wave * 16384);
        bf16_t* wgu = (bf16_t*)(F.ws + WS_WGU); bf16_t* wd = (bf16_t*)(F.ws + WS_WD);
        constexpr int I_G = 16 * 8, I_D = 4 * 32, PER_E = 2 * I_G + I_D;
        for (int it = gw; it < NEXP * PER_E; it += NGW) { const int e = it / PER_E; int r = it % PER_E;
            if (r < I_G) { transpose_item(F.in[IN_WEG] + (size_t)e * D * DEXP, D, DEXP, wgu + (size_t)e * 512 * D, DrGU{0}, scr, r, F.lane); continue; } r -= I_G;
            if (r < I_G) { transpose_item(F.in[IN_WEU] + (size_t)e * D * DEXP, D, DEXP, wgu + (size_t)e * 512 * D, DrGU{1}, scr, r, F.lane); continue; } r -= I_G;
            transpose_item(F.in[IN_WED] + (size_t)e * DEXP * D, DEXP, D, wd + (size_t)e * D * DEXP, DrIdent{0}, scr, r, F.lane); }
    }
    const float* mod = (const float*)(F.ws + WS_MOD); const float* n2w = F.in[IN_N2W]; bf16_t* FL = (bf16_t*)(F.ws + WS_FL);
    for (int row = gw; row < T_LAT; row += NGW) {
        const int b = row / SEQ;
        const GAS f32x4* hr = (const GAS f32x4*)(F.out + (size_t)row * D) + F.lane;
        f32x4 v[4]; float s = 0.f;
#pragma unroll
        for (int j = 0; j < 4; ++j) { v[j] = hr[64 * j]; s += (v[j].x * v[j].x + v[j].y * v[j].y) + (v[j].z * v[j].z + v[j].w * v[j].w); }
        const float rinv = 1.0f / sqrtf(wave_sum(s) * (1.0f / D) + EPS);
        GAS u32x2* o8 = (GAS u32x2*)(FL + (size_t)row * D) + F.lane;
#pragma unroll
        for (int j = 0; j < 4; ++j) { const int col = 256 * j + 4 * F.lane;
            const f32x4 w = *(const f32x4*)(n2w + col), sh = *(const f32x4*)(mod + b * NMOD + 3 * D + col), sc = *(const f32x4*)(mod + b * NMOD + 4 * D + col);
            v[j] = (v[j] * rinv) * w * (sc + 1.0f) + sh;
            u32x2 o; o.x = pk2(v[j].x, v[j].y); o.y = pk2(v[j].z, v[j].w); o8[64 * j] = o; }
    }
}
struct EpiLogits { static constexpr bool PERM = false; float* LG;
    __device__ __forceinline__ void operator()(const f32x4 (&acc)[2][2][4][2], const pg8::Unit& u, int wr, int wc, int fr, int fq) const {
        const int row0 = u.pm * 256 + wr * 64 + fr, col0 = wc * 32 + 4 * fq;
#pragma unroll
        for (int ai = 0; ai < 2; ++ai)
#pragma unroll
            for (int m = 0; m < 4; ++m) { float* p = LG + (size_t)(row0 + ai * 128 + m * 16) * 128 + col0;
                *(GAS f32x4*)p = acc[ai][0][m][0]; *(GAS f32x4*)(p + 16) = acc[ai][0][m][1]; }
    }
};
__device__ __forceinline__ void p8_route(Frame& F) {
    const float* LG = (const float*)(F.ws + WS_LG); const float* brg = F.in[IN_BRG]; const float* bre = F.in[IN_BRE];
    unsigned* eid = (unsigned*)(F.ws + WS_ROUT); float* wts = (float*)(F.ws + WS_ROUT) + 2 * T_LAT; unsigned* lists = (unsigned*)(F.ws + WS_LISTS);
    for (int row = blockIdx.x * NTHREADS + F.tid; row < T_LAT; row += F.G * NTHREADS) {
        const float* lp = LG + (size_t)row * 128;
        const f32x4 gh = *(const GAS f32x4*)lp, gl4 = *(const GAS f32x4*)(lp + 64);
        float gl[4] = {gh.x + gl4.x + brg[0], gh.y + gl4.y + brg[1], gh.z + gl4.z + brg[2], gh.w + gl4.w + brg[3]};
        int gs = 0; float gm = gl[0];
#pragma unroll
        for (int g = 1; g < 4; ++g) if (gl[g] > gm) { gm = gl[g]; gs = g; }
        float den = 0.f;
#pragma unroll
        for (int g = 0; g < 4; ++g) den += expf(gl[g] - gm);
        const float pgrp = 1.0f / den;
        const f32x4 h0 = *(const GAS f32x4*)(lp + 4 + 8 * gs), h1 = *(const GAS f32x4*)(lp + 8 + 8 * gs), l0 = *(const GAS f32x4*)(lp + 68 + 8 * gs), l1 = *(const GAS f32x4*)(lp + 72 + 8 * gs);
        const f32x4 b0 = *(const f32x4*)(bre + 8 * gs), b1 = *(const f32x4*)(bre + 8 * gs + 4);
        const float el[8] = {h0.x + l0.x + b0.x, h0.y + l0.y + b0.y, h0.z + l0.z + b0.z, h0.w + l0.w + b0.w, h1.x + l1.x + b1.x, h1.y + l1.y + b1.y, h1.z + l1.z + b1.z, h1.w + l1.w + b1.w};
        int i0 = 0; float v0 = el[0];
#pragma unroll
        for (int j = 1; j < 8; ++j) if (el[j] > v0) { v0 = el[j]; i0 = j; }
        int i1 = -1; float v1 = -3.0e38f;
#pragma unroll
        for (int j = 0; j < 8; ++j) if (j != i0 && el[j] > v1) { v1 = el[j]; i1 = j; }
        const float e1 = expf(v1 - v0), w0 = pgrp / (1.0f + e1), w1 = pgrp * e1 / (1.0f + e1);
        const int ex0 = gs * 8 + i0, ex1 = gs * 8 + i1;
        const unsigned p0 = __hip_atomic_fetch_add((unsigned*)(F.ctl + CW_CNT + ex0 * 64), 1u, RLX_AGENT);
        const unsigned p1 = __hip_atomic_fetch_add((unsigned*)(F.ctl + CW_CNT + (32 + ex1) * 64), 1u, RLX_AGENT);
        lists[(size_t)ex0 * T_LAT + p0] = (unsigned)row; lists[(size_t)(32 + ex1) * T_LAT + p1] = (unsigned)row;
        eid[row] = (unsigned)ex0; eid[T_LAT + row] = (unsigned)ex1; wts[row] = w0; wts[T_LAT + row] = w1;
    }
}

__device__ __forceinline__ void moe_table(Frame& F) {
    volatile LAS int* ts = (volatile LAS int*)(F.lds + MISC_OFF + 256); volatile LAS int* cn = ts + 80;
    if (F.tid < 64) cn[F.tid] = (int)__hip_atomic_load((unsigned*)(F.ctl + CW_CNT + F.tid * 64), RLX_AGENT);
    __syncthreads();
    if (F.tid == 0) { int a = 0; for (int g = 0; g < 64; ++g) { ts[g] = a; a += (cn[g] + 255) >> 8; } ts[64] = a; }
    __syncthreads();
}
struct Moe1Order { static constexpr bool GATHER = true; const char* FLb; const char* Wgu; const unsigned* lists; const LAS int* ts; const LAS int* cn; int G, c;
    __device__ __forceinline__ bool next(int i, pg8::Unit& u) const { const long L = (long)i * G + c; const int T = (int)(L >> 1); if (T >= ts[64]) return false;
        int g = 0; while (ts[g + 1] <= T) ++g;
        u.pm = T; u.pn = (int)(L & 1); u.x0 = g; u.x1 = (T - ts[g]) * 256; return true; }
    __device__ __forceinline__ const char* aptr(const pg8::Unit&) const { return FLb; }
    __device__ __forceinline__ const char* bptr(const pg8::Unit& u) const { return Wgu + ((size_t)(u.x0 & 31) * 512 + (size_t)u.pn * 256) * D * 2; }
    __device__ __forceinline__ void aoff(const pg8::Unit& u, int tid, unsigned (&off)[2][2]) const { const int n = cn[u.x0];
#pragma unroll
        for (int i = 0; i < 2; ++i) { int R, C; pg8::stage_rc(tid * 16 + i * 8192, R, C);
#pragma unroll
            for (int h = 0; h < 2; ++h) { const int idx = u.x1 + h * 128 + R; const unsigned tok = idx < n ? lists[(size_t)u.x0 * T_LAT + idx] : 0u; off[h][i] = tok * (unsigned)(D * 2) + (unsigned)(C * 2); } } }
};
struct EpiMoe1 { static constexpr bool PERM = true; bf16_t* H;
    __device__ __forceinline__ void operator()(const f32x4 (&acc)[2][2][4][2], const pg8::Unit& u, int wr, int wc, int fr, int fq) const {
        const int row0 = u.pm * 256 + wr * 64 + fr, col0 = u.pn * 128 + 16 * wc + 4 * fq;
#pragma unroll
        for (int ai = 0; ai < 2; ++ai)
#pragma unroll
            for (int m = 0; m < 4; ++m)
#pragma unroll
                for (int bj = 0; bj < 2; ++bj) { const f32x4 g = acc[ai][bj][m][0], up = acc[ai][bj][m][1];
                    u32x2 w; w.x = cvt_pk_bf16(siluf_(g[0]) * up[0], siluf_(g[1]) * up[1]); w.y = cvt_pk_bf16(siluf_(g[2]) * up[2], siluf_(g[3]) * up[3]);
                    *(GAS u32x2*)(H + (size_t)(row0 + ai * 128 + m * 16) * DEXP + col0 + 64 * bj) = w; }
    }
};
struct Moe2Order { static constexpr bool GATHER = false; const char* Hb; const char* Wd; const LAS int* ts; const LAS int* cn; int slot, G, c;
    __device__ __forceinline__ bool next(int i, pg8::Unit& u) const { const long L = (long)i * G + c; const int T = ts[slot * 32] + (int)(L >> 2); if (T >= ts[slot * 32 + 32]) return false;
        int g = slot * 32; while (ts[g + 1] <= T) ++g;
        u.pm = T; u.pn = (int)(L & 3); u.x0 = g; u.x1 = (T - ts[g]) * 256; return true; }
    __device__ __forceinline__ const char* aptr(const pg8::Unit& u) const { return Hb + (size_t)u.pm * 256 * DEXP * 2; }
    __device__ __forceinline__ const char* bptr(const pg8::Unit& u) const { return Wd + ((size_t)(u.x0 & 31) * D + (size_t)u.pn * 256) * DEXP * 2; }
    __device__ __forceinline__ void aoff(const pg8::Unit&, int, unsigned (&)[2][2]) const {}
};
struct EpiMoe2 { static constexpr bool PERM = false; float* out; const float* mod; const unsigned* lists; const float* wts; const LAS int* cn; int slot;
    __device__ __forceinline__ void operator()(const f32x4 (&acc)[2][2][4][2], const pg8::Unit& u, int wr, int wc, int fr, int fq) const {
        const int n = cn[u.x0], col0 = u.pn * 256 + wc * 32 + 4 * fq;
#pragma unroll
        for (int ai = 0; ai < 2; ++ai)
#pragma unroll
            for (int m = 0; m < 4; ++m) { const int idx = u.x1 + ai * 128 + wr * 64 + m * 16 + fr;
                if (idx < n) { const unsigned tok = lists[(size_t)u.x0 * T_LAT + idx]; const float w = wts[(size_t)slot * T_LAT + tok]; const float* g2 = mod + (size_t)(tok / SEQ) * NMOD + 5 * D; float* op = out + (size_t)tok * D;
#pragma unroll
                    for (int bj = 0; bj < 2; ++bj)
#pragma unroll
                        for (int nn = 0; nn < 2; ++nn) { const int col = col0 + bj * 128 + nn * 16; const f32x4 gv = *(const f32x4*)(g2 + col); const f32x4 ov = *(const GAS f32x4*)(op + col);
                            *(GAS f32x4*)(op + col) = ov + (gv * w) * acc[ai][bj][m][nn]; } }
                asm volatile("" ::: "memory"); }
    }
};

#ifndef MK_N_LAUNCHES
#define MK_N_LAUNCHES 1
#endif
constexpr int N_PHASES = 12;
constexpr int N_LAUNCHES = MK_N_LAUNCHES;
struct Args { const float* in[23]; float* out; unsigned char* ws; int ph_lo, ph_hi, kd, pad; };
__global__ void __launch_bounds__(NTHREADS, 2) fwd_kernel(Args args) {
    extern __shared__ __attribute__((aligned(16))) unsigned char lds[];
    Frame F;
    F.lds = (LAS unsigned char*)lds;
    F.tid = threadIdx.x; F.lane = F.tid & 63; F.wave = __builtin_amdgcn_readfirstlane(F.tid >> 6);
    F.G = gridDim.x; { const int bx = blockIdx.x; F.vcu = (F.G % 8 == 0) ? (bx % 8) * (F.G / 8) + bx / 8 : bx; }
    F.ws = args.ws; F.out = args.out; F.ctl = (gu32*)(args.ws + WS_CTL);
#pragma unroll
    for (int i = 0; i < 23; ++i) F.in[i] = args.in[i];
    for (int u = F.tid; u < (LDS_BYTES - MISC_OFF) / 4; u += NTHREADS) ((LAS unsigned*)(F.lds + MISC_OFF))[u] = 0u;
    __syncthreads();
    XcdBarrier bar; bar.bar = (unsigned*)(F.ctl + CW_BAR); bar.x = 0; bar.st = nullptr;
    if (N_LAUNCHES == 1) bar = xcd_barrier_post((unsigned*)(F.ctl + CW_BAR), (volatile LAS unsigned*)(F.lds + MISC_OFF + 32));
    const int lo = args.ph_lo, hi = args.ph_hi;
#ifndef PH_MASK
#define PH_MASK 0xFFF
#endif
#define IN(k) ((((PH_MASK) >> (k)) & 1) && lo <= (k) && (k) < hi)
#define SEAM(k) do { if (IN(k) && IN((k) + 1)) xcd_barrier(bar); STAMP((k) + 1); } while (0)
#if defined(PROBE_SEL)
#define STAMP(k) do { if (blockIdx.x == 0 && F.tid == 0) ((volatile LAS unsigned long long*)(F.lds + MISC_OFF + 4096))[k] = __builtin_amdgcn_s_memrealtime(); } while (0)
#else
#define STAMP(k) do { } while (0)
#endif
    STAMP(0);

    if (IN(0)) { p0_prologue(F); } SEAM(0);
    if (IN(1)) { p1_a0(F); } SEAM(1);
    if (IN(2)) {
        InProjOrder S{(const char*)(F.ws + WS_A0), (const char*)(F.ws + WS_WIN), F.G, (int)blockIdx.x};
        EpiInProj E{F.ws, (bf16_t*)F.out, F.in[IN_BMG], F.in[IN_QNW], F.in[IN_KNW], F.lds};
        pg8::gemm_phase<EpiInProj, InProjOrder, true>(F.lds, D, S, E);
    } SEAM(2);
    if (IN(3)) { p4_mixers(F); } SEAM(3);
    if (IN(4)) {
        RectOrder S{(const char*)(F.ws + WS_MQ), (const char*)(F.ws + WS_AQ), (const char*)(F.ws + WS_WBM), MT_LAT, 4, 2 * D, D, F.G, (int)blockIdx.x};
        EpiMerge E{(const bf16_t*)F.out, (bf16_t*)(F.ws + WS_Z)};
        pg8::gemm_phase<EpiMerge, RectOrder, true, true>(F.lds, 2 * D, S, E);
    } SEAM(4);
    if (IN(5)) {
        RectOrder S{(const char*)(F.ws + WS_Z), nullptr, (const char*)(F.ws + WS_WO), MT_LAT, 4, D, D, F.G, (int)blockIdx.x};
        EpiOut E{F.in[IN_X], (const float*)(F.ws + WS_MOD), F.out};
        pg8::gemm_phase<EpiOut, RectOrder, true>(F.lds, D, S, E);
    } SEAM(5);
    if (IN(6)) { p6_fl(F); } SEAM(6);
    if (IN(7)) {
        RectOrder S{(const char*)(F.ws + WS_FL), nullptr, (const char*)(F.ws + WS_WR), MT_LAT, 1, D, D, F.G, (int)blockIdx.x};
        EpiLogits E{(float*)(F.ws + WS_LG)};
        pg8::gemm_phase<EpiLogits, RectOrder, true>(F.lds, D, S, E);
    } SEAM(7);
    if (IN(8)) { p8_route(F); } SEAM(8);
    if (IN(9)) {
        moe_table(F);
        const LAS int* ts = (const LAS int*)(F.lds + MISC_OFF + 256);
        Moe1Order S{(const char*)(F.ws + WS_FL), (const char*)(F.ws + WS_WGU), (const unsigned*)(F.ws + WS_LISTS), ts, ts + 80, F.G, (int)blockIdx.x};
        EpiMoe1 E{(bf16_t*)(F.ws + WS_H)};
        pg8::gemm_phase<EpiMoe1, Moe1Order, true>(F.lds, D, S, E);
    } SEAM(9);
    if (IN(10)) {
        moe_table(F);
        const LAS int* ts = (const LAS int*)(F.lds + MISC_OFF + 256);
        Moe2Order S{(const char*)(F.ws + WS_H), (const char*)(F.ws + WS_WD), ts, ts + 80, 0, F.G, (int)blockIdx.x};
        EpiMoe2 E{F.out, (const float*)(F.ws + WS_MOD), (const unsigned*)(F.ws + WS_LISTS), (const float*)(F.ws + WS_ROUT) + 2 * T_LAT, ts + 80, 0};
        pg8::gemm_phase<EpiMoe2, Moe2Order, true>(F.lds, args.kd, S, E);
    } SEAM(10);
    if (IN(11)) {
        moe_table(F);
        const LAS int* ts = (const LAS int*)(F.lds + MISC_OFF + 256);
        Moe2Order S{(const char*)(F.ws + WS_H), (const char*)(F.ws + WS_WD), ts, ts + 80, 1, F.G, (int)blockIdx.x};
        EpiMoe2 E{F.out, (const float*)(F.ws + WS_MOD), (const unsigned*)(F.ws + WS_LISTS), (const float*)(F.ws + WS_ROUT) + 2 * T_LAT, ts + 80, 1};
        pg8::gemm_phase<EpiMoe2, Moe2Order, true>(F.lds, args.kd, S, E);
    }
#if defined(PROBE_SEL)
    STAMP(12);
    if (blockIdx.x == 0 && F.tid == 0) { volatile LAS unsigned long long* ts = (volatile LAS unsigned long long*)(F.lds + MISC_OFF + 4096);
        const unsigned long long dt = (PROBE_SEL >= 14 ? ts[PROBE_SEL] : PROBE_SEL == 13 ? ts[13] - ts[3] : ts[PROBE_SEL + 1] - ts[PROBE_SEL]) * PROBE_MULT; const unsigned long long t0 = __builtin_amdgcn_s_memrealtime();
        while (__builtin_amdgcn_s_memrealtime() - t0 < dt) __builtin_amdgcn_s_sleep(8); }
#endif
#undef IN
#undef SEAM
}

extern "C" void kernel_launch(void* const* d_in, const int* in_sizes, int n_in, void* d_out, int out_size, void* d_ws, size_t ws_size, hipStream_t stream) {
    static int grid = 0;
    if (grid == 0) {
        if (n_in != 23 || out_size != T_LAT * D || ws_size < WS_END) { fprintf(stderr, "kernel_launch: unexpected shapes (n_in %d out %d ws %zu)\n", n_in, out_size, ws_size); grid = -1; return; }
        int dev = 0, cus = 0;
        if (hipGetDevice(&dev) != hipSuccess || hipDeviceGetAttribute(&cus, hipDeviceAttributeMultiprocessorCount, dev) != hipSuccess) { grid = -1; return; }
        if (hipFuncSetAttribute((const void*)fwd_kernel, hipFuncAttributeMaxDynamicSharedMemorySize, LDS_BYTES) != hipSuccess) { fprintf(stderr, "kernel_launch: hipFuncSetAttribute failed\n"); grid = -1; return; }
        int per_cu = 0;
        if (hipOccupancyMaxActiveBlocksPerMultiprocessor(&per_cu, (const void*)fwd_kernel, NTHREADS, LDS_BYTES) != hipSuccess || per_cu < 1) fprintf(stderr, "kernel_launch: occupancy query says %d\n", per_cu);
        (void)hipGetLastError();
        grid = cus;
    }
    if (grid < 0) return;
    if (hipMemsetAsync((char*)d_ws + WS_CTL, 0, CTL_ZERO_BYTES, stream) != hipSuccess) return;
    Args a{};
    for (int i = 0; i < 23; ++i) a.in[i] = (const float*)d_in[i];
    a.out = (float*)d_out; a.ws = (unsigned char*)d_ws; a.kd = DEXP; a.pad = 0;
    if (N_LAUNCHES == 1) { a.ph_lo = 0; a.ph_hi = N_PHASES; hipLaunchKernelGGL(fwd_kernel, dim3(grid), dim3(NTHREADS), LDS_BYTES, stream, a); }
    else for (int p = 0; p < N_PHASES; ++p) { a.ph_lo = p; a.ph_hi = p + 1; hipLaunchKernelGGL(fwd_kernel, dim3(grid), dim3(NTHREADS), LDS_BYTES, stream, a); }
    const hipError_t le = hipPeekAtLastError();
    if (le != hipSuccess) fprintf(stderr, "kernel_launch: launch failed: %s\n", hipGetErrorName(le));
}
```

```cpp
#include <hip/hip_runtime.h>
#include <cstdio>
#include <cstdint>

#define LAS __attribute__((address_space(3)))
#define GAS __attribute__((address_space(1)))
typedef unsigned short bf16_t;
typedef short bf16x8 __attribute__((ext_vector_type(8)));
typedef short s16x4 __attribute__((ext_vector_type(4)));
typedef float f32x4 __attribute__((ext_vector_type(4)));
typedef float f32x2 __attribute__((ext_vector_type(2)));
typedef float f32x16 __attribute__((ext_vector_type(16)));
typedef unsigned u32x4 __attribute__((ext_vector_type(4)));
typedef unsigned u32x2 __attribute__((ext_vector_type(2)));
typedef GAS unsigned gu32;

constexpr int D = 1024, NB = 16, SEQ = 2048, CTXL = 256;
constexpr int T_LAT = NB * SEQ, T_CTX = NB * CTXL, T_ALL = T_LAT + T_CTX;
constexpr int IN_W = 7712, NMOD = 6 * D;
constexpr int KVL = SEQ + CTXL;
constexpr int NEXP = 32, DEXP = 256;
constexpr float EPS = 1e-6f;
constexpr int NWAVES = 8, NTHREADS = 512;

constexpr int NT_LAT = 31, NT_CTX = 11, NW_IN = NT_LAT * 256;
constexpr int MT_LAT = T_LAT / 256, MT_CTX = T_CTX / 256;

constexpr size_t MiB = 1u << 20;
constexpr size_t WS_CTL = 0, CTL_ZERO_BYTES = 1 * MiB;
constexpr size_t WS_MOD = 1 * MiB;
constexpr size_t WS_ROPE = 1 * MiB + 512 * 1024;
constexpr size_t WS_GATES = 2 * MiB;
constexpr size_t WS_WBM = 7 * MiB, WS_WO = 11 * MiB;
constexpr size_t WS_WR = 28 * MiB + 512 * 1024;
constexpr size_t WS_WIN = 13 * MiB;
constexpr size_t WS_ROUT = 29 * MiB;
constexpr size_t WS_LISTS = 30 * MiB;
constexpr size_t WS_A0 = 38 * MiB;
constexpr size_t WS_MQ = 110 * MiB;
constexpr size_t WS_MK = 174 * MiB;
constexpr size_t WS_MV = 246 * MiB;
constexpr size_t WS_OG = 318 * MiB;
constexpr size_t WS_AQ = 382 * MiB;
constexpr size_t WS_AK = 446 * MiB;
constexpr size_t WS_AV = 464 * MiB;
constexpr size_t WS_END = 482 * MiB;
constexpr size_t WS_WGU = WS_A0, WS_WD = WS_A0 + 32 * MiB;
constexpr size_t WS_Z = WS_MK, WS_FL = WS_MV, WS_H = WS_OG, WS_HTMP = WS_A0;
constexpr size_t WS_LG = WS_AK;
constexpr size_t WS_LW = WS_AV;
constexpr size_t WS_Y = WS_MQ;

constexpr int CW_TMO = 0, CW_ATTQ = 64, CW_BAR = 4096;
constexpr int CW_CNT = 8192;
constexpr int LDS_BYTES = 155648;
constexpr int MISC_OFF = 147456;

#define RLX_AGENT __ATOMIC_RELAXED, __HIP_MEMORY_SCOPE_AGENT
#define LDS_WAIT() asm volatile("s_waitcnt lgkmcnt(0)" ::: "memory")
#define VM_WAIT() asm volatile("s_waitcnt vmcnt(0)" ::: "memory")

__device__ __forceinline__ unsigned f2bf(float f) { unsigned u = __builtin_bit_cast(unsigned, f); return (u + 0x7fffu + ((u >> 16) & 1u)) >> 16; }
__device__ __forceinline__ unsigned pk2(float lo, float hi) { return f2bf(lo) | (f2bf(hi) << 16); }
__device__ __forceinline__ float bf2f(unsigned short b) { return __builtin_bit_cast(float, ((unsigned)b) << 16); }
__device__ __forceinline__ float bflo(unsigned w) { return __builtin_bit_cast(float, w << 16); }
__device__ __forceinline__ float bfhi(unsigned w) { return __builtin_bit_cast(float, w & 0xffff0000u); }
typedef __bf16 bf16x2_t __attribute__((ext_vector_type(2)));
__device__ __forceinline__ unsigned cvt_pk_bf16(float lo, float hi) { const f32x2 v = {lo, hi}; const bf16x2_t b = __builtin_convertvector(v, bf16x2_t); return __builtin_bit_cast(unsigned, b); }
__device__ __forceinline__ float wave_sum(float v) {
#pragma unroll
    for (int o = 1; o < 64; o <<= 1) v += __shfl_xor(v, o);
    return v;
}
__device__ __forceinline__ float wave_max(float v) {
#pragma unroll
    for (int o = 1; o < 64; o <<= 1) v = fmaxf(v, __shfl_xor(v, o));
    return v;
}
__device__ __forceinline__ float sigmoidf_(float x) { return 1.0f / (1.0f + __expf(-x)); }
__device__ __forceinline__ float siluf_(float x) { return x / (1.0f + __expf(-x)); }

#define XB_TMO      128
#define XB_XCNT(j)  (256  + 64 * (j))
#define XB_XSUB(j)  (1280 + 64 * (j))
#define XB_XGEN(j)  (2304 + 64 * (j))
#define XB_TOP      3328
#define XB_TOPGEN   3392
#define XCD_BAR_WORDS 3456
#define XB_SPIN_CAP (1u << 18)

__device__ __forceinline__ unsigned xb_ld(unsigned* p)              { return __hip_atomic_load(p, __ATOMIC_RELAXED, __HIP_MEMORY_SCOPE_AGENT); }
__device__ __forceinline__ unsigned xb_add(unsigned* p, unsigned v) { return __hip_atomic_fetch_add(p, v, __ATOMIC_RELAXED, __HIP_MEMORY_SCOPE_AGENT); }
__device__ __forceinline__ unsigned xb_xcc_id() { return (unsigned)__builtin_amdgcn_s_getreg((3 << 11) | 20) & 0xFu; }
#define XB_SPIN(cond, bar) do { unsigned _sp = 0; while (cond) { __builtin_amdgcn_s_sleep(1); \
    if ((++_sp & 255u) == 0u) { if (xb_ld(&(bar)[XB_TMO])) break; if (_sp > XB_SPIN_CAP) { atomicAdd(&(bar)[XB_TMO], 1u); break; } } } } while (0)

struct XcdBarrier {
    unsigned* bar; unsigned x;
    volatile LAS unsigned* st;
};

__device__ __forceinline__ XcdBarrier xcd_barrier_post(unsigned* bar, volatile LAS unsigned* st) {
    XcdBarrier b; b.bar = bar; b.x = xb_xcc_id(); b.st = st;
    if (threadIdx.x == 0) (void)xb_add(&bar[XB_XCNT(b.x)], 1u);
    return b;
}
__device__ __forceinline__ void xcd_barrier_complete(unsigned* bar, unsigned x, unsigned& nloc, unsigned& nx) {
    const unsigned G = gridDim.x * gridDim.y * gridDim.z;
    unsigned sum, cnt, mine, sp = 0u;
    for (;;) {
        sum = 0u; cnt = 0u; mine = 0u;
#pragma unroll
        for (unsigned j = 0; j < 16; ++j) { const unsigned c = xb_ld(&bar[XB_XCNT(j)]); sum += c; cnt += (c > 0u) ? 1u : 0u; mine = (j == x) ? c : mine; }
        if (sum == G) break;
        __builtin_amdgcn_s_sleep(1);
        if ((++sp & 255u) == 0u) { if (xb_ld(&bar[XB_TMO])) break; if (sp > XB_SPIN_CAP) { atomicAdd(&bar[XB_TMO], 1u); break; } }
    }
    nloc = mine > 0u ? mine : 1u; nx = cnt > 0u ? cnt : 1u;
}

__device__ __forceinline__ void xcd_barrier(const XcdBarrier& b) {
    asm volatile("s_waitcnt vmcnt(0)" ::: "memory");
    __syncthreads();
    if (threadIdx.x == 0) {
        unsigned* bar = b.bar;
        __builtin_amdgcn_s_waitcnt(0);
        unsigned nloc = b.st[0], nx = b.st[1];
        if (nloc == 0u) { xcd_barrier_complete(bar, b.x, nloc, nx); b.st[0] = nloc; b.st[1] = nx; }
        const unsigned old = xb_add(&bar[XB_XSUB(b.x)], 1u);
        const unsigned gen = old / nloc;
        if (old + 1u == (gen + 1u) * nloc) {
            __builtin_amdgcn_fence(__ATOMIC_RELEASE, "agent");
            asm volatile("s_waitcnt vmcnt(0)" ::: "memory");
            const unsigned og = xb_add(&bar[XB_TOP], 1u);
            const unsigned tg = og / nx;
            if (og + 1u == (tg + 1u) * nx) xb_add(&bar[XB_TOPGEN], 1u);
            else XB_SPIN(xb_ld(&bar[XB_TOPGEN]) == tg, bar);
            __builtin_amdgcn_fence(__ATOMIC_ACQUIRE, "agent");
            xb_add(&bar[XB_XGEN(b.x)], 1u);
            asm volatile("s_waitcnt vmcnt(0)" ::: "memory");
        } else {
            XB_SPIN(xb_ld(&bar[XB_XGEN(b.x)]) == gen, bar);
            __builtin_amdgcn_fence(__ATOMIC_ACQUIRE, "agent");
            asm volatile("s_waitcnt vmcnt(0)" ::: "memory");
        }
    }
    __syncthreads();
}

namespace pg8 {
constexpr int BM = 256, BK = 64, HALF = 128, HTB = HALF * BK * 2  , STAGE_BYTES = 8 * HTB, NXCD = 8, WGM = 8;
__host__ __device__ __forceinline__ int lds_byte(int r, int c) { const int st = (r >> 4) * 2 + (c >> 5), rr = r & 15, cc = c & 31, ob = rr * 64 + cc * 2; return st * 1024 + (ob ^ (((ob >> 9) & 1) << 5)); }
__host__ __device__ __forceinline__ void stage_rc(int b, int& R, int& C) { const int st = b / 1024, sb = b % 1024, swz = sb ^ (((sb >> 9) & 1) << 5); R = (st >> 1) * 16 + swz / 64; C = (st & 1) * 32 + (swz % 64) / 2; }
__host__ __device__ __forceinline__ int perm32(int rho) { const int n = rho >> 4, i = rho & 15; return 8 * (i >> 2) + 4 * n + (i & 3); }

struct Unit { int pm, pn, x0, x1; };
__device__ __forceinline__ void tile_of(int wgid, int nM, int nN, int& pm, int& pn) {
    const int nwg = nM * nN; { const int q = nwg / NXCD, r = nwg % NXCD, xcd = wgid % NXCD, off = wgid / NXCD; wgid = (xcd < r ? xcd * (q + 1) : r * (q + 1) + (xcd - r) * q) + off; }
    const int nig = WGM * nN, gid = wgid / nig, fm = gid * WGM, gsz = (nM - fm) < WGM ? (nM - fm) : WGM;
    pm = fm + ((wgid % nig) % gsz); pn = (wgid % nig) / gsz;
}

template <class Epi, class Sched, bool ALIGN_EPI, bool DUAL = false>
__device__ __forceinline__ void gemm_phase(LAS unsigned char* lds, const int K, const Sched& S, const Epi& E) {
    const int tid = threadIdx.x, wid = __builtin_amdgcn_readfirstlane(tid >> 6), lane = tid & 63, wr = wid >> 2, wc = wid & 3, fr = lane & 15, fq = lane >> 4;
    const int nt = K / BK;
    unsigned voffA[2], voffB[2];
#pragma unroll
    for (int i = 0; i < 2; ++i) { int R, C; stage_rc(tid * 16 + i * 8192, R, C); const int Rb = Epi::PERM ? ((R & ~31) + perm32(R & 31)) : R;
        voffA[i] = (unsigned)(R * (DUAL ? K / 2 : K) + C) * 2u; voffB[i] = (unsigned)(Rb * K + C) * 2u; }
    const size_t kstep = (size_t)(BK * 2);
    const size_t hstep = (size_t)HALF * K * 2;
    const size_t hstepA = (size_t)HALF * (DUAL ? K / 2 : K) * 2;
    const unsigned ldsw = (unsigned)wid * 1024u;
    const int aoff = lds_byte(wr * 64 + fr, fq * 8), boff = lds_byte(wc * 32 + fr, fq * 8);
#define PG8_SA(b, h) (((b) * 2 + (h)) * HTB)
#define PG8_SB(b, h) ((4 + (b) * 2 + (h)) * HTB)
#define PG8_STAGE(bufoff, gbase, voff) do { _Pragma("unroll") for (int _i = 0; _i < 2; ++_i) \
        __builtin_amdgcn_global_load_lds((const unsigned*)((const char*)(gbase) + (voff)[_i]), (LAS unsigned*)(lds + (bufoff) + ldsw + _i * 8192), 16, 0, 0); } while (0)
#define PG8_STAGE_A(bufoff, base, h, NX) do { if constexpr (Sched::GATHER) { _Pragma("unroll") for (int _i = 0; _i < 2; ++_i) { const unsigned _o = (NX) ? gN[h][_i] : gA[h][_i]; \
        __builtin_amdgcn_global_load_lds((const unsigned*)((const char*)(base) + _o), (LAS unsigned*)(lds + (bufoff) + ldsw + _i * 8192), 16, 0, 0); } } \
        else { PG8_STAGE(bufoff, (const char*)(base) + (h) * hstepA, voffA); } } while (0)
#define PG8_LDA(dst, b, h) do { _Pragma("unroll") for (int m = 0; m < 4; ++m) _Pragma("unroll") for (int k = 0; k < 2; ++k) dst[m][k] = *(const LAS bf16x8*)(lds + PG8_SA(b, h) + aoff + m * 2048 + k * 1024); } while (0)
#define PG8_LDB(dst, b, h) do { _Pragma("unroll") for (int n = 0; n < 2; ++n) _Pragma("unroll") for (int k = 0; k < 2; ++k) dst[n][k] = *(const LAS bf16x8*)(lds + PG8_SB(b, h) + boff + n * 2048 + k * 1024); } while (0)
#define PG8_MMA(ai, bj, At, Bt) do { __builtin_amdgcn_s_setprio(1); _Pragma("unroll") for (int m = 0; m < 4; ++m) _Pragma("unroll") for (int n = 0; n < 2; ++n) _Pragma("unroll") for (int k = 0; k < 2; ++k) \
        acc[ai][bj][m][n] = __builtin_amdgcn_mfma_f32_16x16x32_bf16(Bt[n][k], At[m][k], acc[ai][bj][m][n], 0, 0, 0); __builtin_amdgcn_s_setprio(0); } while (0)
#define PG8_WAIT_V(n) asm volatile("s_waitcnt vmcnt(" #n ")" ::: "memory")
#define PG8_WAIT_L(n) asm volatile("s_waitcnt lgkmcnt(" #n ")" ::: "memory")
#define PG8_BAR __builtin_amdgcn_s_barrier()
#define PG8_SCHED __builtin_amdgcn_sched_barrier(0)
#define PG8_AKT(p1, p2, kt) ((DUAL && (kt) >= nt / 2) ? (p2) + (size_t)((kt) - nt / 2) * kstep : (p1) + (size_t)(kt) * kstep)
    Unit cur, nxt; int ui = 0;
    if (!S.next(0, cur)) return;
    f32x4 acc[2][2][4][2];
#pragma unroll
    for (int a = 0; a < 2; ++a)
#pragma unroll
        for (int b = 0; b < 2; ++b)
#pragma unroll
            for (int m = 0; m < 4; ++m)
#pragma unroll
                for (int n = 0; n < 2; ++n) acc[a][b][m][n] = (f32x4){0.f, 0.f, 0.f, 0.f};
    bf16x8 At[4][2], B0[2][2], B1[2][2];
    unsigned gA[2][2] = {{0u, 0u}, {0u, 0u}}, gN[2][2] = {{0u, 0u}, {0u, 0u}};
    const char* cA = S.aptr(cur); const char* cB = S.bptr(cur); const char* cA2 = cA; const char* nA2 = cA;
    if constexpr (DUAL) cA2 = S.aptr2(cur);
    if constexpr (Sched::GATHER) S.aoff(cur, tid, gA);
    PG8_STAGE(PG8_SB(0, 0), cB, voffB); PG8_STAGE(PG8_SB(0, 1), cB + hstep, voffB); PG8_STAGE_A(PG8_SA(0, 0), cA, 0, false); PG8_STAGE_A(PG8_SA(0, 1), cA, 1, false);
    if (wr == 1) PG8_BAR;
    PG8_WAIT_V(2); PG8_BAR;
    PG8_STAGE(PG8_SB(1, 0), cB + kstep, voffB); PG8_STAGE_A(PG8_SA(1, 0), cA + kstep, 0, false); PG8_STAGE(PG8_SB(1, 1), cB + hstep + kstep, voffB);
    PG8_WAIT_V(6); PG8_BAR;
    for (;;) {
        const bool has_next = S.next(ui + 1, nxt);
        const char* nA = has_next ? S.aptr(nxt) : cA; const char* nB = has_next ? S.bptr(nxt) : cB;
        if constexpr (DUAL) nA2 = has_next ? S.aptr2(nxt) : cA2;
        if constexpr (Sched::GATHER) { if (has_next) S.aoff(nxt, tid, gN); else {
#pragma unroll
            for (int h = 0; h < 2; ++h) { gN[h][0] = gA[h][0]; gN[h][1] = gA[h][1]; } } }
        for (int t = 0; t < nt; t += 2) {
            const bool last = (t == nt - 2);
            const char* a1 = PG8_AKT(cA, cA2, t + 1);
            const char* a2 = last ? nA : PG8_AKT(cA, cA2, t + 2); const char* b2 = last ? nB : cB + (size_t)(t + 2) * kstep;
            const char* a3 = last ? nA + kstep : PG8_AKT(cA, cA2, t + 3); const char* b3 = b2 + kstep;
            if constexpr (DUAL) { if (t == nt / 2) E.mid(acc, cur, wr, wc, fr, fq); }
            PG8_LDB(B0, 0, 0); PG8_LDB(B1, 0, 1); PG8_SCHED; PG8_LDA(At, 0, 0); PG8_STAGE_A(PG8_SA(1, 1), a1, 1, false);
            PG8_WAIT_V(8); PG8_WAIT_L(0); PG8_BAR; PG8_MMA(0, 0, At, B0); PG8_MMA(0, 1, At, B1); PG8_BAR; PG8_SCHED;
            PG8_LDA(At, 0, 1); PG8_STAGE(PG8_SB(0, 0), b2, voffB); PG8_STAGE(PG8_SB(0, 1), b2 + hstep, voffB); PG8_STAGE_A(PG8_SA(0, 0), a2, 0, last);
            PG8_WAIT_V(8); PG8_WAIT_L(0); PG8_BAR; PG8_MMA(1, 0, At, B0); PG8_MMA(1, 1, At, B1); PG8_BAR; PG8_SCHED;
            PG8_LDB(B0, 1, 0); PG8_LDB(B1, 1, 1); PG8_SCHED; PG8_LDA(At, 1, 0); PG8_STAGE_A(PG8_SA(0, 1), a2, 1, last);
            PG8_WAIT_V(8); PG8_WAIT_L(0); PG8_BAR; PG8_MMA(0, 0, At, B0); PG8_MMA(0, 1, At, B1); PG8_BAR; PG8_SCHED;
            PG8_LDA(At, 1, 1); PG8_STAGE(PG8_SB(1, 0), b3, voffB); PG8_STAGE(PG8_SB(1, 1), b3 + hstep, voffB); PG8_STAGE_A(PG8_SA(1, 0), a3, 0, last);
            PG8_WAIT_V(8); PG8_WAIT_L(0); PG8_BAR; PG8_MMA(1, 0, At, B0); PG8_MMA(1, 1, At, B1); PG8_BAR; PG8_SCHED;
        }
        if constexpr (ALIGN_EPI) { if (wr == 0) PG8_BAR; }
        E(acc, cur, wr, wc, fr, fq);
        if (!has_next) break;
#pragma unroll
        for (int a = 0; a < 2; ++a)
#pragma unroll
            for (int b = 0; b < 2; ++b)
#pragma unroll
                for (int m = 0; m < 4; ++m)
#pragma unroll
                    for (int n = 0; n < 2; ++n) acc[a][b][m][n] = (f32x4){0.f, 0.f, 0.f, 0.f};
        cur = nxt; cA = nA; cB = nB; ++ui; if constexpr (DUAL) cA2 = nA2;
        if constexpr (Sched::GATHER) {
#pragma unroll
            for (int h = 0; h < 2; ++h) { gA[h][0] = gN[h][0]; gA[h][1] = gN[h][1]; } }
        if constexpr (ALIGN_EPI) { if (wr == 1) PG8_BAR; }
    }
    PG8_WAIT_V(0);
    if constexpr (!ALIGN_EPI) { if (wr == 0) PG8_BAR; }
    PG8_BAR;
#undef PG8_AKT
#undef PG8_SA
#undef PG8_SB
#undef PG8_STAGE
#undef PG8_STAGE_A
#undef PG8_LDA
#undef PG8_LDB
#undef PG8_MMA
#undef PG8_WAIT_V
#undef PG8_WAIT_L
#undef PG8_BAR
#undef PG8_SCHED
}
}

struct Frame {
    LAS unsigned char* lds;
    gu32* ctl;
    int tid, lane, wave, G, vcu;
    const float* in[23]; float* out; unsigned char* ws;
};
#define IN_X 0
#define IN_C 1
#define IN_CTX 2
#define IN_CCTX 3
#define IN_WADA 4
#define IN_BADA 5
#define IN_N1W 6
#define IN_WIN 7
#define IN_BMG 8
#define IN_QNW 9
#define IN_KNW 10
#define IN_MHW 11
#define IN_WBM 12
#define IN_WBA 13
#define IN_WOUT 14
#define IN_N2W 15
#define IN_WRG 16
#define IN_BRG 17
#define IN_WRE 18
#define IN_BRE 19
#define IN_WEG 20
#define IN_WEU 21
#define IN_WED 22

__device__ __forceinline__ void p0_ada(Frame& F) {
    LAS float* sl = (LAS float*)F.lds;
    LAS float* red = sl + 17 * 1024;
    const float* cc = F.in[IN_C]; const float* cx = F.in[IN_CCTX];
    for (int i = F.tid; i < 17 * 1024; i += NTHREADS) { const int r = i >> 10, k = i & 1023; const float c = r < 16 ? cc[r * 1024 + k] : cx[k]; sl[i] = siluf_(c); }
    __syncthreads();
    const float* W = F.in[IN_WADA]; const float* bias = F.in[IN_BADA]; float* mod = (float*)(F.ws + WS_MOD);
    const int j = F.lane & 31, kk = F.lane >> 5;
    for (int cb = blockIdx.x; cb < 256; cb += F.G) {
        const int col0 = cb * 24;
        float acc[17];
#pragma unroll
        for (int r = 0; r < 17; ++r) acc[r] = 0.f;
        if (j < 24) {
#pragma unroll 1
            for (int i0 = 0; i0 < 64; i0 += 32) { float wv[32];
#pragma unroll
                for (int it = 0; it < 32; ++it) wv[it] = W[(size_t)(F.wave * 128 + (i0 + it) * 2 + kk) * NMOD + col0 + j];
#pragma unroll
                for (int it = 0; it < 32; ++it) { const int k = F.wave * 128 + (i0 + it) * 2 + kk;
#pragma unroll
                    for (int r = 0; r < 17; ++r) acc[r] += sl[r * 1024 + k] * wv[it]; } }
        }
#pragma unroll
        for (int r = 0; r < 17; ++r) acc[r] += __shfl_xor(acc[r], 32);
        if (F.lane < 32) {
#pragma unroll
            for (int r = 0; r < 17; ++r) red[(F.wave * 17 + r) * 32 + j] = acc[r]; }
        __syncthreads();
        if (F.tid < 17 * 24) { const int r = F.tid / 24, jj = F.tid % 24; float s = 0.f;
#pragma unroll
            for (int w = 0; w < 8; ++w) s += red[(w * 17 + r) * 32 + jj];
            mod[r * NMOD + col0 + jj] = s + bias[col0 + jj]; }
        __syncthreads();
    }
}
template <class DR>
__device__ __forceinline__ void transpose_item(const float* W, int K, int N, bf16_t* WT, const DR& destrow, LAS float* scr, int item, int lane, int ldw = 0, int koff = 0) {
    if (ldw == 0) ldw = K;
    const int nblk = N / 32, kb = item / nblk, nb = item % nblk, k0 = 64 * kb, n0 = 32 * nb;
    float tv[32];
#pragma unroll
    for (int i = 0; i < 32; ++i) tv[i] = W[(size_t)(k0 + 2 * i + (lane >> 5)) * N + n0 + (lane & 31)];
#pragma unroll
    for (int i = 0; i < 32; ++i) scr[(2 * i + (lane >> 5)) * 33 + (lane & 31)] = tv[i];
    LDS_WAIT(); asm volatile("" ::: "memory");
    const int c = lane & 7;
#pragma unroll
    for (int j = 0; j < 4; ++j) { const int n = (lane >> 3) + 8 * j; const LAS float* s = scr + (8 * c) * 33 + n;
        u32x4 o; o.x = pk2(s[0 * 33], s[1 * 33]); o.y = pk2(s[2 * 33], s[3 * 33]); o.z = pk2(s[4 * 33], s[5 * 33]); o.w = pk2(s[6 * 33], s[7 * 33]);
        *(GAS u32x4*)(WT + (size_t)destrow(n0 + n) * ldw + koff + k0 + 8 * c) = o; }
    LDS_WAIT(); asm volatile("" ::: "memory");
}
struct DrIdent { int off; __device__ __forceinline__ int operator()(int n) const { return off + n; } };
__device__ __forceinline__ int qk_pos(int d) { const int half = d >> 6, dl = d & 63, n = dl >> 5, i = dl & 31; return 32 * (2 * half + (i >> 4)) + 8 * ((i >> 2) & 3) + 4 * n + (i & 3); }
struct DrWin { __device__ __forceinline__ int operator()(int n) const {
    if (n < 1024) return 2816 + n;
    if (n < 2048) return n - 1024;
    if (n < 3072) return 1024 + (n - 2048);
    if (n < 4096) return 3840 + (n - 3072);
    if (n < 4128) return 2560 + (n - 4096);
    if (n < 5152) { const int q = n - 4128; return 4864 + (q & ~127) + qk_pos(q & 127); }
    if (n < 5408) { const int q = n - 5152; return 2048 + (q & ~127) + qk_pos(q & 127); }
    if (n < 5664) return 2304 + (n - 5408);
    return 5888 + (n - 5664); } };
__device__ __forceinline__ void p0_prologue(Frame& F) {
    p0_ada(F);
    __syncthreads();
    LAS float* scr = (LAS float*)(F.lds + F.wave * 16384);
    const int gw = F.vcu * NWAVES + F.wave, NGW = F.G * NWAVES;
    constexpr int I_IN = 16 * (IN_W / 32), I_SQ = 16 * 32;
    bf16_t* win_t = (bf16_t*)(F.ws + WS_WIN);
    for (int it = gw; it < I_IN + 3 * I_SQ; it += NGW) {
        int r = it;
        if (r < I_IN) { transpose_item(F.in[IN_WIN], D, IN_W, win_t, DrWin{}, scr, r, F.lane); continue; } r -= I_IN;
        if (r < I_SQ) { transpose_item(F.in[IN_WBM], D, D, (bf16_t*)(F.ws + WS_WBM), DrIdent{0}, scr, r, F.lane, 2 * D, 0); continue; } r -= I_SQ;
        if (r < I_SQ) { transpose_item(F.in[IN_WBA], D, D, (bf16_t*)(F.ws + WS_WBM), DrIdent{0}, scr, r, F.lane, 2 * D, D); continue; } r -= I_SQ;
        transpose_item(F.in[IN_WOUT], D, D, (bf16_t*)(F.ws + WS_WO), DrIdent{0}, scr, r, F.lane);
    }
    { GAS u32x4* z = (GAS u32x4*)(win_t + (size_t)2592 * D); const int n16 = 224 * D * 2 / 16;
      for (int i = blockIdx.x * NTHREADS + F.tid; i < n16; i += F.G * NTHREADS) z[i] = (u32x4){0u, 0u, 0u, 0u}; }
    { bf16_t* wr = (bf16_t*)(F.ws + WS_WR); const float* wrg = F.in[IN_WRG]; const float* wre = F.in[IN_WRE];
      for (int i = blockIdx.x * NTHREADS + F.tid; i < 256 * D; i += F.G * NTHREADS) { const int o = i >> 10, k = i & 1023; const int oo = o < 36 ? o : ((o >= 64 && o < 100) ? o - 64 : -1);
          unsigned v = 0u; if (oo >= 0) { const float w = oo < 4 ? wrg[k * 4 + oo] : wre[k * 32 + oo - 4]; const unsigned hi = f2bf(w); v = o < 36 ? hi : f2bf(w - __builtin_bit_cast(float, hi << 16)); }
          wr[i] = (bf16_t)v; } }
    { float* tab = (float*)(F.ws + WS_ROPE);
      for (int i = blockIdx.x * NTHREADS + F.tid; i < 2048; i += F.G * NTHREADS) { const int pos = i >> 5, fi = i & 31;
          const float inv = powf(10000.0f, -(float)(2 * fi) / 64.0f); const float ang = (float)pos * inv; tab[i] = cosf(ang); tab[2048 + i] = sinf(ang); } }
}

__device__ __forceinline__ void p1_a0(Frame& F) {
    const int gw = F.vcu * NWAVES + F.wave, NGW = F.G * NWAVES;
    const float* mod = (const float*)(F.ws + WS_MOD); const float* n1w = F.in[IN_N1W]; bf16_t* A0 = (bf16_t*)(F.ws + WS_A0);
    constexpr int RB = 4;
    for (int row0 = gw; row0 < T_ALL; row0 += RB * NGW) {
        f32x4 v[RB][4];
#pragma unroll
        for (int q = 0; q < RB; ++q) { const int row = row0 + q * NGW; if (row < T_ALL) {
            const float* src = row < T_LAT ? F.in[IN_X] + (size_t)row * D : F.in[IN_CTX] + (size_t)(row - T_LAT) * D; const GAS f32x4* xr = (const GAS f32x4*)src + F.lane;
#pragma unroll
            for (int j = 0; j < 4; ++j) v[q][j] = xr[64 * j]; } }
#pragma unroll
        for (int q = 0; q < RB; ++q) { const int row = row0 + q * NGW; if (row < T_ALL) {
            const int mr = row < T_LAT ? row / SEQ : 16; float s = 0.f;
#pragma unroll
            for (int j = 0; j < 4; ++j) s += (v[q][j].x * v[q][j].x + v[q][j].y * v[q][j].y) + (v[q][j].z * v[q][j].z + v[q][j].w * v[q][j].w);
            const float rinv = 1.0f / sqrtf(wave_sum(s) * (1.0f / D) + EPS);
            GAS u32x2* o8 = (GAS u32x2*)(A0 + (size_t)row * D) + F.lane;
#pragma unroll
            for (int j = 0; j < 4; ++j) { const int col = 256 * j + 4 * F.lane;
                const f32x4 w = *(const f32x4*)(n1w + col), sh = *(const f32x4*)(mod + mr * NMOD + col), sc = *(const f32x4*)(mod + mr * NMOD + D + col);
                const f32x4 y = (v[q][j] * rinv) * w * (sc + 1.0f) + sh;
                u32x2 o; o.x = cvt_pk_bf16(y.x, y.y); o.y = cvt_pk_bf16(y.z, y.w); o8[64 * j] = o; } } }
    }
}

struct InProjOrder { static constexpr bool GATHER = false; const char* A; const char* Bt; int G, c;
    __device__ __forceinline__ bool next(int i, pg8::Unit& u) const { const long L = (long)i * G + c; constexpr int NL = MT_LAT * NT_LAT, NC = MT_CTX * NT_CTX; if (L >= NL + NC) return false;
        if (L < NL) pg8::tile_of((int)L, MT_LAT, NT_LAT, u.pm, u.pn); else { const int q = (int)L - NL; u.pm = MT_LAT + q % MT_CTX; u.pn = q / MT_CTX; } u.x0 = 0; u.x1 = 0; return true; }
    __device__ __forceinline__ const char* aptr(const pg8::Unit& u) const { return A + (size_t)u.pm * (256 * D * 2); }
    __device__ __forceinline__ const char* bptr(const pg8::Unit& u) const { return Bt + (size_t)u.pn * (256 * D * 2); }
    __device__ __forceinline__ void aoff(const pg8::Unit&, int, unsigned (&)[2][2]) const {}
};
__device__ __forceinline__ int krow_of(int r0) { if (r0 < T_LAT) return (r0 / SEQ) * KVL + (r0 % SEQ); const int q = r0 - T_LAT; return (q / CTXL) * KVL + SEQ + (q % CTXL); }
struct EpiInProj { static constexpr bool PERM = true; unsigned char* ws; bf16_t* mg; const float* bgate; const float* qnw; const float* knw; LAS unsigned char* lds;
    __device__ __forceinline__ void operator()(const f32x4 (&acc)[2][2][4][2], const pg8::Unit& u, int wr, int wc, int fr, int fq) const {
        const int pn = u.pn; int r0 = u.pm * 256; bf16_t* base; int ldc = D, colt;
        if (pn == 10) {
            if (wc == 0) { float* g = (float*)(ws + WS_GATES); const f32x4 b0 = *(const f32x4*)(bgate + 8 * fq), b1 = *(const f32x4*)(bgate + 8 * fq + 4);
#pragma unroll
                for (int ai = 0; ai < 2; ++ai)
#pragma unroll
                    for (int m = 0; m < 4; ++m) { float* p = g + (size_t)(r0 + ai * 128 + wr * 64 + m * 16 + fr) * 32 + 8 * fq;
                        *(f32x4*)p = acc[ai][0][m][0] + b0; *(f32x4*)(p + 4) = acc[ai][0][m][1] + b1; } }
            return; }
        const bool isk = pn == 8, isq = pn >= 19 && pn < 23;
        const int t0 = u.pm < MT_LAT ? (r0 % SEQ) : -1;
        if (pn < 4) { base = (bf16_t*)(ws + WS_MK); colt = pn * 256; }
        else if (pn < 8) { base = (bf16_t*)(ws + WS_MV); colt = (pn - 4) * 256; }
        else if (pn < 10) { base = (bf16_t*)(ws + (pn == 8 ? WS_AK : WS_AV)); ldc = 256; colt = 0; r0 = krow_of(r0); }
        else if (pn < 15) { base = (bf16_t*)(ws + WS_MQ); colt = (pn - 11) * 256; }
        else if (pn < 19) { base = (bf16_t*)(ws + WS_OG); colt = (pn - 15) * 256; }
        else if (pn < 23) { base = (bf16_t*)(ws + WS_AQ); colt = (pn - 19) * 256; }
        else { base = mg; ldc = 2 * D; colt = (pn - 23) * 256; }
        const int row0 = r0 + wr * 64 + fr, col0 = colt + wc * 32 + 8 * fq;
        if (isk || isq) {
            LAS float* xs = (LAS float*)(lds + pg8::STAGE_BYTES);
#pragma unroll
            for (int ai = 0; ai < 2; ++ai)
#pragma unroll
                for (int m = 0; m < 4; ++m)
#pragma unroll
                    for (int bj = 0; bj < 2; ++bj) { const f32x4 a = acc[ai][bj][m][0], b = acc[ai][bj][m][1];
                        float ss = (a[0] * a[0] + a[1] * a[1]) + (a[2] * a[2] + a[3] * a[3]) + (b[0] * b[0] + b[1] * b[1]) + (b[2] * b[2] + b[3] * b[3]);
                        ss += __shfl_xor(ss, 16); ss += __shfl_xor(ss, 32);
                        if (fq == 0) xs[(bj * 256 + ai * 128 + wr * 64 + m * 16 + fr) * 4 + wc] = ss; }
            LDS_WAIT(); __builtin_amdgcn_s_barrier(); asm volatile("" ::: "memory");
            const float* nw = isk ? knw : qnw; const float* tab = (const float*)(ws + WS_ROPE);
            const int dlo = 64 * (wc >> 1) + 16 * (wc & 1) + 4 * fq;
            const f32x4 w0 = *(const f32x4*)(nw + dlo), w1 = *(const f32x4*)(nw + dlo + 32);
#pragma unroll
            for (int ai = 0; ai < 2; ++ai)
#pragma unroll
                for (int m = 0; m < 4; ++m) { const int rl = ai * 128 + wr * 64 + m * 16 + fr; bf16_t* rowp = base + (size_t)(row0 + ai * 128 + m * 16) * ldc + col0;
                    f32x4 cs = (f32x4){1.f, 1.f, 1.f, 1.f}, sn = (f32x4){0.f, 0.f, 0.f, 0.f};
                    if (t0 >= 0) { const int t = t0 + rl; const int pos = (wc >> 1) ? (t & 63) : (t >> 6); cs = *(const f32x4*)(tab + pos * 32 + 16 * (wc & 1) + 4 * fq); sn = *(const f32x4*)(tab + 2048 + pos * 32 + 16 * (wc & 1) + 4 * fq); }
#pragma unroll
                    for (int bj = 0; bj < 2; ++bj) { const f32x4 p4 = *(const LAS f32x4*)(xs + (bj * 256 + rl) * 4);
                        const float rinv = 1.0f / sqrtf(((p4.x + p4.y) + (p4.z + p4.w)) * (1.0f / 128.0f) + EPS);
                        const f32x4 x1 = (acc[ai][bj][m][0] * rinv) * w0, x2 = (acc[ai][bj][m][1] * rinv) * w1;
                        const f32x4 y1 = x1 * cs - x2 * sn, y2 = x2 * cs + x1 * sn;
                        u32x4 w; w.x = cvt_pk_bf16(y1[0], y1[1]); w.y = cvt_pk_bf16(y1[2], y1[3]); w.z = cvt_pk_bf16(y2[0], y2[1]); w.w = cvt_pk_bf16(y2[2], y2[3]);
                        *(u32x4*)(rowp + bj * 128) = w; } }
            return; }
#pragma unroll
        for (int ai = 0; ai < 2; ++ai)
#pragma unroll
            for (int m = 0; m < 4; ++m) { bf16_t* rowp = base + (size_t)(row0 + ai * 128 + m * 16) * ldc + col0;
#pragma unroll
                for (int bj = 0; bj < 2; ++bj) { const f32x4 v0 = acc[ai][bj][m][0], v1 = acc[ai][bj][m][1];
                    u32x4 w; w.x = cvt_pk_bf16(v0[0], v0[1]); w.y = cvt_pk_bf16(v0[2], v0[3]); w.z = cvt_pk_bf16(v1[0], v1[1]); w.w = cvt_pk_bf16(v1[2], v1[3]);
                    *(u32x4*)(rowp + bj * 128) = w; } }
    }
};


namespace ml {
typedef short v4i16_t __attribute__((ext_vector_type(4)));
constexpr int PQ = 272, PT = 144;
constexpr int QS = 0, KS = 16384, VS = 32768;
constexpr int HST = QS;
constexpr int CT = 49152;
constexpr int PP = CT + 128 * PQ;
constexpr int SC = PP + 64 * PT;
constexpr int T_A = 0, T_PM = 36 * 64, T_B = 2 * 36 * 64, T_MP = 3 * 36 * 64, T_DS = T_MP + 36, T_WO = T_DS + 36, T_BL = T_WO + 36, T_AM = T_BL + 36;
constexpr int S_RS0 = T_AM + 36 + 12, S_RS1 = S_RS0 + 64, S_QN = S_RS1 + 64, S_N = S_QN + 64;
constexpr int END = SC + (S_N + 128) * 4;
static_assert(END <= MISC_OFF && (S_RS0 % 4) == 0, "mLSTM LDS map");
constexpr float QSCALE = 0.08838834764831845f;

__device__ __forceinline__ int off_b(int row, int ch) { return 256 * row + 16 * (ch ^ (((row & 3) << 2) | ((row >> 2) & 3))); }
struct LaneAddr { int rbase, xm64, tb0, tb1, xc32; };
__device__ __forceinline__ LaneAddr lane_addr(int lane) {
    const int fr = lane & 15, fq = lane >> 4, mr = ((fr & 3) << 2) | ((fr >> 2) & 3); LaneAddr a;
    a.rbase = 256 * fr + 16 * (fq ^ (mr & 3)); a.xm64 = 64 * (mr >> 2);
    const int g = lane >> 4, q = (lane & 15) >> 2, p = lane & 3;
    a.tb0 = 256 * (8 * g + q) + 16 * (p >> 1) + 8 * (p & 1); a.tb1 = 256 * (8 * g + q + 4) + 16 * ((p >> 1) ^ 1) + 8 * (p & 1); a.xc32 = 32 * ((q << 1) | (g & 1));
    return a;
}
__device__ __forceinline__ bf16x8 rfrag(const LAS unsigned char* base, int rb, int s, const LaneAddr& A) { return *(const LAS bf16x8*)(base + (A.rbase + ((64 * s) ^ A.xm64)) + 4096 * rb); }
__device__ __forceinline__ bf16x8 tfrag(const LAS unsigned char* base, int c, int ks, const LaneAddr& A) {
    const int o = (32 * c) ^ A.xc32;
    const v4i16_t a = __builtin_amdgcn_ds_read_tr16_b64_v4i16((LAS v4i16_t*)(base + (A.tb0 + o) + 8192 * ks));
    const v4i16_t b = __builtin_amdgcn_ds_read_tr16_b64_v4i16((LAS v4i16_t*)(base + (A.tb1 + o) + 8192 * ks));
    return (bf16x8){a[0], a[1], a[2], a[3], b[0], b[1], b[2], b[3]};
}
__device__ __forceinline__ bf16x8 pfrag(const LAS unsigned char* base, int pitch, int tile, int ks, int lane) {
    return *(const LAS bf16x8*)(base + (16 * tile + (lane & 15)) * pitch + (32 * ks + 8 * (lane >> 4)) * 2);
}
__device__ __forceinline__ float logsig(float x) { return fminf(x, 0.f) - __logf(1.0f + __expf(-fabsf(x))); }
__device__ __forceinline__ unsigned mulpk(unsigned w, float a, float b) { return cvt_pk_bf16(bflo(w) * a, bfhi(w) * b); }

__device__ __forceinline__ void unit(Frame& F, int b, int h) {
    LAS unsigned char* L = F.lds; LAS float* sc = (LAS float*)(L + SC);
    const int tid = F.tid, lane = F.lane, w = F.wave;
    const bf16_t* MQ = (const bf16_t*)(F.ws + WS_MQ); const bf16_t* MK = (const bf16_t*)(F.ws + WS_MK); const bf16_t* MV = (const bf16_t*)(F.ws + WS_MV);
    const bf16_t* OG = (const bf16_t*)(F.ws + WS_OG); bf16_t* HT = (bf16_t*)(F.ws + WS_HTMP); bf16_t* AM = (bf16_t*)(F.ws + WS_MQ);
    const float* GT = (const float*)(F.ws + WS_GATES); const float* mhw = F.in[IN_MHW];
    const int lr = tid >> 3, seg = tid & 7;
    const int wo0 = off_b(lr, 2 * seg), wo1 = off_b(lr, 2 * seg + 1);
    LaneAddr LA = lane_addr(lane);
    for (int dir = 0; dir < 2; ++dir) {
#define ML_GROW(st, r) ((st) < 4 ? (T_LAT + b * CTXL + (dir == 0 ? (st) * 64 + (r) : (3 - (st)) * 64 + 63 - (r))) : (b * SEQ + (dir == 0 ? ((st) - 4) * 64 + (r) : (35 - (st)) * 64 + 63 - (r))))
        for (int st = w; st < 36; st += 8) {
            const float* gp = GT + (size_t)ML_GROW(st, lane) * 32 + dir * 16 + h; const float g_i = gp[0], g_f = gp[8];
            float bc = logsig(g_f);
#pragma unroll
            for (int o = 1; o < 64; o <<= 1) { const float t = __shfl_up(bc, o); if (lane >= o) bc += t; }
            const float a = g_i - bc;
            float pm = a;
#pragma unroll
            for (int o = 1; o < 64; o <<= 1) { const float t = __shfl_up(pm, o); if (lane >= o) pm = fmaxf(pm, t); }
            sc[T_A + st * 64 + lane] = a; sc[T_PM + st * 64 + lane] = pm; sc[T_B + st * 64 + lane] = bc;
            if (lane == 63) { sc[T_BL + st] = bc; sc[T_AM + st] = pm; }
        }
        f32x4 accC[8], accN = (f32x4){0.f, 0.f, 0.f, 0.f};
#pragma unroll
        for (int e = 0; e < 8; ++e) accC[e] = (f32x4){0.f, 0.f, 0.f, 0.f};
        for (int i = tid; i < 128 * PQ / 4; i += NTHREADS) ((LAS unsigned*)(L + CT))[i] = 0u;
        if (tid < 128) sc[S_N + tid] = 0.f;
        LDS_WAIT(); __syncthreads();
        if (tid == 0) { float m = -1e30f;
            for (int st = 0; st < 36; ++st) { const float bl = sc[T_BL + st], mx = fmaxf(m, sc[T_AM + st]); sc[T_MP + st] = m; sc[T_DS + st] = -mx; sc[T_WO + st] = __expf(m - mx); m = bl + mx; } }
        u32x4 rq0, rq1, rk0, rk1, rv0, rv1;
        rq0 = rq1 = rk0 = rk1 = rv0 = rv1 = (u32x4){0u, 0u, 0u, 0u};
#define ML_LOAD(st) do { const size_t go = (size_t)ML_GROW(st, lr) * D + h * 128 + seg * 16; \
            if ((st) >= 4) { rq0 = *(const GAS u32x4*)(MQ + go); rq1 = *(const GAS u32x4*)(MQ + go + 8); } \
            rk0 = *(const GAS u32x4*)(MK + go); rk1 = *(const GAS u32x4*)(MK + go + 8); rv0 = *(const GAS u32x4*)(MV + go); rv1 = *(const GAS u32x4*)(MV + go + 8); } while (0)
#define ML_WRITE(st) do { if ((st) >= 4) { *(LAS u32x4*)(L + QS + wo0) = rq0; *(LAS u32x4*)(L + QS + wo1) = rq1; } \
            *(LAS u32x4*)(L + KS + wo0) = rk0; *(LAS u32x4*)(L + KS + wo1) = rk1; *(LAS u32x4*)(L + VS + wo0) = rv0; *(LAS u32x4*)(L + VS + wo1) = rv1; } while (0)
        ML_LOAD(0);
        ML_WRITE(0);
        ML_LOAD(1);
#if defined(PROBE_SEL)
        volatile LAS unsigned long long* pts = (volatile LAS unsigned long long*)(F.lds + MISC_OFF + 4096 + 8 * 24);
        if (blockIdx.x == 0 && tid == 0) { pts[3] = 0; pts[4] = 0; pts[5] = 0; }
#endif
        for (int st = 0; st < 36; ++st) {
            const bool lat = st >= 4;
            const LAS float* ta = sc + T_A + st * 64; const LAS float* tpm = sc + T_PM + st * 64; const LAS float* tb = sc + T_B + st * 64;
            LDS_WAIT(); __syncthreads();
            asm volatile("" : "+v"(LA.rbase), "+v"(LA.xm64), "+v"(LA.tb0), "+v"(LA.tb1), "+v"(LA.xc32));
#if defined(PROBE_SEL)
            if (blockIdx.x == 0 && tid == 0) { const unsigned long long t = __builtin_amdgcn_s_memrealtime(); if (st > 0) pts[5] += t - pts[2]; pts[0] = t; }
#endif
            const float mprev = sc[T_MP + st], dsc = sc[T_DS + st], wold = sc[T_WO + st];
            f32x4 acch[4];
            const int si = w >> 1, eb = 4 * (w & 1);
            if (lat) {
                bf16x8 qf[4];
#pragma unroll
                for (int ks = 0; ks < 4; ++ks) qf[ks] = rfrag(L + QS, si, ks, LA);
                const int s_col = 16 * si + (lane & 15); const float Ms = fmaxf(mprev, tpm[s_col]);
                float psum = 0.f;
#pragma unroll
                for (int rr = 0; rr < 2; ++rr) { const int ri = 2 * (w & 1) + rr; f32x4 a4 = (f32x4){0.f, 0.f, 0.f, 0.f};
#pragma unroll
                    for (int ks = 0; ks < 4; ++ks) a4 = __builtin_amdgcn_mfma_f32_16x16x32_bf16(rfrag(L + KS, ri, ks, LA), qf[ks], a4, 0, 0, 0);
                    const int r0 = 16 * ri + 4 * (lane >> 4); const f32x4 av = *(const LAS f32x4*)(ta + r0); float p[4];
#pragma unroll
                    for (int j = 0; j < 4; ++j) { const int r = r0 + j; p[j] = (r <= s_col) ? a4[j] * QSCALE * __expf(av[j] - Ms) : 0.f; psum += p[j]; }
                    u32x2 pw; pw.x = cvt_pk_bf16(p[0], p[1]); pw.y = cvt_pk_bf16(p[2], p[3]);
                    *(LAS u32x2*)(L + PP + s_col * PT + r0 * 2) = pw; }
                psum += __shfl_xor(psum, 16); psum += __shfl_xor(psum, 32);
                if (lane < 16) sc[((w & 1) ? S_RS1 : S_RS0) + s_col] = psum;
                { const u32x4 q0 = *(const LAS u32x4*)(L + QS + wo0), q1 = *(const LAS u32x4*)(L + QS + wo1);
                  const LAS f32x4* nv = (const LAS f32x4*)(sc + S_N + seg * 16); const f32x4 n0 = nv[0], n1 = nv[1], n2 = nv[2], n3 = nv[3];
                  float d = bflo(q0.x) * n0.x + bfhi(q0.x) * n0.y + bflo(q0.y) * n0.z + bfhi(q0.y) * n0.w + bflo(q0.z) * n1.x + bfhi(q0.z) * n1.y + bflo(q0.w) * n1.z + bfhi(q0.w) * n1.w
                          + bflo(q1.x) * n2.x + bfhi(q1.x) * n2.y + bflo(q1.y) * n2.z + bfhi(q1.y) * n2.w + bflo(q1.z) * n3.x + bfhi(q1.z) * n3.y + bflo(q1.w) * n3.z + bfhi(q1.w) * n3.w;
                  d += __shfl_xor(d, 1); d += __shfl_xor(d, 2); d += __shfl_xor(d, 4);
                  if (seg == 0) sc[S_QN + lr] = d; }
#pragma unroll
                for (int e = 0; e < 4; ++e) { acch[e] = (f32x4){0.f, 0.f, 0.f, 0.f};
#pragma unroll
                    for (int ks = 0; ks < 4; ++ks) acch[e] = __builtin_amdgcn_mfma_f32_16x16x32_bf16(pfrag(L + CT, PQ, eb + e, ks, lane), qf[ks], acch[e], 0, 0, 0); }
            }
            LDS_WAIT(); __syncthreads();
#if defined(PROBE_SEL)
            if (blockIdx.x == 0 && tid == 0) { const unsigned long long t = __builtin_amdgcn_s_memrealtime(); pts[3] += t - pts[0]; pts[1] = t; }
#endif
            {
                bf16x8 ka0 = tfrag(L + KS, w, 0, LA), ka1 = tfrag(L + KS, w, 1, LA);
                {
                    const LAS f32x4* ap = (const LAS f32x4*)(ta + 8 * (lane >> 4)); const f32x4 a0 = ap[0], a1 = ap[1], a2 = ap[8], a3 = ap[9];
                    u32x4 k0 = __builtin_bit_cast(u32x4, ka0), k1 = __builtin_bit_cast(u32x4, ka1);
                    k0.x = mulpk(k0.x, __expf(a0.x + dsc), __expf(a0.y + dsc)); k0.y = mulpk(k0.y, __expf(a0.z + dsc), __expf(a0.w + dsc)); k0.z = mulpk(k0.z, __expf(a1.x + dsc), __expf(a1.y + dsc)); k0.w = mulpk(k0.w, __expf(a1.z + dsc), __expf(a1.w + dsc));
                    k1.x = mulpk(k1.x, __expf(a2.x + dsc), __expf(a2.y + dsc)); k1.y = mulpk(k1.y, __expf(a2.z + dsc), __expf(a2.w + dsc)); k1.z = mulpk(k1.z, __expf(a3.x + dsc), __expf(a3.y + dsc)); k1.w = mulpk(k1.w, __expf(a3.z + dsc), __expf(a3.w + dsc));
                    ka0 = __builtin_bit_cast(bf16x8, k0); ka1 = __builtin_bit_cast(bf16x8, k1); }
#pragma unroll
                for (int e = 0; e < 8; ++e) { accC[e] = accC[e] * wold;
                    accC[e] = __builtin_amdgcn_mfma_f32_16x16x32_bf16(ka0, tfrag(L + VS, e, 0, LA), accC[e], 0, 0, 0);
                    accC[e] = __builtin_amdgcn_mfma_f32_16x16x32_bf16(ka1, tfrag(L + VS, e, 1, LA), accC[e], 0, 0, 0);
                    u32x2 cw; cw.x = cvt_pk_bf16(accC[e][0], accC[e][1]); cw.y = cvt_pk_bf16(accC[e][2], accC[e][3]);
                    *(LAS u32x2*)(L + CT + (16 * e + (lane & 15)) * PQ + (16 * w + 4 * (lane >> 4)) * 2) = cw; }
                { const unsigned one2 = ((lane & 15) == 0) ? 0x3f803f80u : 0u; const u32x4 ob = (u32x4){one2, one2, one2, one2};
                  accN = accN * wold;
                  accN = __builtin_amdgcn_mfma_f32_16x16x32_bf16(ka0, __builtin_bit_cast(bf16x8, ob), accN, 0, 0, 0);
                  accN = __builtin_amdgcn_mfma_f32_16x16x32_bf16(ka1, __builtin_bit_cast(bf16x8, ob), accN, 0, 0, 0);
                  if ((lane & 15) == 0) *(LAS f32x4*)(sc + S_N + 16 * w + 4 * (lane >> 4)) = accN; }
            }
            if (lat) {
                const int s = 16 * si + (lane & 15);
                const float M = fmaxf(mprev, tpm[s]); const float rwi = QSCALE * __expf(mprev - M);
                const float den = rwi * sc[S_QN + s] + sc[S_RS0 + s] + sc[S_RS1 + s]; const float rden = 1.0f / fmaxf(fabsf(den), __expf(-(tb[s] + M)));
                const bf16x8 pf0 = pfrag(L + PP, PT, si, 0, lane), pf1 = pfrag(L + PP, PT, si, 1, lane);
                const int hrow = 256 * s, hmask = ((s & 3) << 2) | ((s >> 2) & 3), g = lane >> 4;
#pragma unroll
                for (int e = 0; e < 4; ++e) {
                    acch[e] = acch[e] * rwi;
                    acch[e] = __builtin_amdgcn_mfma_f32_16x16x32_bf16(tfrag(L + VS, eb + e, 0, LA), pf0, acch[e], 0, 0, 0);
                    acch[e] = __builtin_amdgcn_mfma_f32_16x16x32_bf16(tfrag(L + VS, eb + e, 1, LA), pf1, acch[e], 0, 0, 0);
                    const f32x4 hv = acch[e] * rden;
                    u32x2 hw; hw.x = cvt_pk_bf16(hv[0], hv[1]); hw.y = cvt_pk_bf16(hv[2], hv[3]);
                    *(LAS u32x2*)(L + HST + hrow + 16 * ((2 * (eb + e) + (g >> 1)) ^ hmask) + 8 * (g & 1)) = hw; }
            }
            LDS_WAIT(); __syncthreads();
#if defined(PROBE_SEL)
            if (blockIdx.x == 0 && tid == 0) { const unsigned long long t = __builtin_amdgcn_s_memrealtime(); pts[4] += t - pts[1]; pts[2] = t; }
#endif
            {
                const size_t go = (size_t)ML_GROW(st, lr) * D + h * 128 + seg * 16;
                u32x4 h0 = (u32x4){0u, 0u, 0u, 0u}, h1 = h0;
                if (lat) { h0 = *(const LAS u32x4*)(L + HST + wo0); h1 = *(const LAS u32x4*)(L + HST + wo1); }
                if (st + 1 < 36) ML_WRITE(st + 1);
                asm volatile("" ::: "memory");
                if (lat) {
                    if (dir == 0) { *(GAS u32x4*)(HT + go) = h0; *(GAS u32x4*)(HT + go + 8) = h1; }
                    else {
                        const u32x4 f0 = *(const GAS u32x4*)(HT + go), f1 = *(const GAS u32x4*)(HT + go + 8), g0 = *(const GAS u32x4*)(OG + go), g1 = *(const GAS u32x4*)(OG + go + 8);
                        const unsigned hw[8] = {h0.x, h0.y, h0.z, h0.w, h1.x, h1.y, h1.z, h1.w}, fw[8] = {f0.x, f0.y, f0.z, f0.w, f1.x, f1.y, f1.z, f1.w}, gw[8] = {g0.x, g0.y, g0.z, g0.w, g1.x, g1.y, g1.z, g1.w};
                        float x[16]; float ss = 0.f;
#pragma unroll
                        for (int j = 0; j < 8; ++j) { x[2 * j] = bflo(hw[j]) + bflo(fw[j]); x[2 * j + 1] = bfhi(hw[j]) + bfhi(fw[j]); ss += x[2 * j] * x[2 * j] + x[2 * j + 1] * x[2 * j + 1]; }
                        ss += __shfl_xor(ss, 1); ss += __shfl_xor(ss, 2); ss += __shfl_xor(ss, 4);
                        const float rinv = 1.0f / sqrtf(ss * (1.0f / 128.0f) + EPS);
                        const float* mw = mhw + h * 128 + seg * 16; unsigned ow[8];
#pragma unroll
                        for (int j = 0; j < 8; ++j) { const float y0 = (x[2 * j] * rinv) * mw[2 * j] * sigmoidf_(bflo(gw[j])), y1 = (x[2 * j + 1] * rinv) * mw[2 * j + 1] * sigmoidf_(bfhi(gw[j])); ow[j] = cvt_pk_bf16(y0, y1); }
                        *(GAS u32x4*)(AM + go) = (u32x4){ow[0], ow[1], ow[2], ow[3]}; *(GAS u32x4*)(AM + go + 8) = (u32x4){ow[4], ow[5], ow[6], ow[7]};
                    }
                }
                asm volatile("" ::: "memory");
                if (st + 2 < 36) ML_LOAD(st + 2);
            }
        }
#if defined(PROBE_SEL)
        if (blockIdx.x == 0 && tid == 0) { volatile LAS unsigned long long* ts = (volatile LAS unsigned long long*)(F.lds + MISC_OFF + 4096); ts[14 + 3 * dir] = pts[3]; ts[15 + 3 * dir] = pts[4]; ts[16 + 3 * dir] = pts[5]; }
#endif
        VM_WAIT(); __syncthreads();
#undef ML_LOAD
#undef ML_WRITE
#undef ML_GROW
    }
}
}

namespace at {
constexpr int QBLK = 32, KVBLK = 64, LDQ = D, LDK = 256, LDO = D;
constexpr float SCALE = 0.088388347648318440f;
constexpr float THR = 8.f;
constexpr size_t SHM_V = KVBLK * 128 * 2, SHM_K = KVBLK * 128 * 2, SHM_ATTN = 2 * SHM_V + 2 * SHM_K + NWAVES * 64 * 4;
#define KSWZ(row, colB) ((row) * 256 + ((colB) ^ (((row) & 7) << 4)))
#define SBAR() __builtin_amdgcn_sched_barrier(0)
__device__ __forceinline__ int crow(int r, int hi) { return (r & 3) + 8 * (r >> 2) + 4 * hi; }
__device__ __forceinline__ void partialSM(f32x16& p0, f32x16& p1, float& m_reg, float& mn, float& alpha) {
  constexpr float C = SCALE * 1.4426950408889634f;
  float pmax = p0[0];
#pragma unroll
  for (int r = 1; r < 16; ++r) pmax = fmaxf(pmax, p0[r]);
#pragma unroll
  for (int r = 0; r < 16; ++r) pmax = fmaxf(pmax, p1[r]);
  { auto rr = __builtin_amdgcn_permlane32_swap(__float_as_uint(pmax), __float_as_uint(pmax), false, false);
    pmax = fmaxf(__uint_as_float(rr[0]), __uint_as_float(rr[1])); }
  if (__builtin_expect(__all(pmax - m_reg <= THR / SCALE), 1)) { mn = m_reg; alpha = 1.f; }
  else { mn = fmaxf(m_reg, pmax); alpha = __builtin_amdgcn_exp2f((m_reg - mn) * C); m_reg = mn; }
  float mnC = -mn * C;
#pragma unroll
  for (int r = 0; r < 16; ++r) p0[r] = fmaf(p0[r], C, mnC);
#pragma unroll
  for (int r = 0; r < 16; ++r) p1[r] = fmaf(p1[r], C, mnC);
#pragma unroll
  for (int r = 0; r < 16; ++r) p0[r] = __builtin_amdgcn_exp2f(p0[r]);
}
__device__ __forceinline__ void finishSM(f32x16& p0, f32x16& p1, float alpha, float& l_reg, bf16x8& pa0, bf16x8& pa1, bf16x8& pa2, bf16x8& pa3) {
#pragma unroll
  for (int r = 0; r < 16; ++r) p1[r] = __builtin_amdgcn_exp2f(p1[r]);
  float ps = 0;
#pragma unroll
  for (int r = 0; r < 16; ++r) ps += p0[r];
#pragma unroll
  for (int r = 0; r < 16; ++r) ps += p1[r];
  { auto rr = __builtin_amdgcn_permlane32_swap(__float_as_uint(ps), __float_as_uint(ps), false, false);
    ps = __uint_as_float(rr[0]) + __uint_as_float(rr[1]); }
  l_reg = l_reg * alpha + ps;
#define PK4(P, BASE, OUT) do { unsigned a0 = cvt_pk_bf16(P[BASE + 0], P[BASE + 1]), a1 = cvt_pk_bf16(P[BASE + 2], P[BASE + 3]);   \
    unsigned b0 = cvt_pk_bf16(P[BASE + 4], P[BASE + 5]), b1 = cvt_pk_bf16(P[BASE + 6], P[BASE + 7]);                              \
    auto r0 = __builtin_amdgcn_permlane32_swap(a0, b0, false, false); auto r1 = __builtin_amdgcn_permlane32_swap(a1, b1, false, false); \
    u32x4 w = {r0[0], r1[0], r0[1], r1[1]}; OUT = *reinterpret_cast<bf16x8*>(&w); } while (0)
  PK4(p0, 0, pa0); PK4(p0, 8, pa1); PK4(p1, 0, pa2); PK4(p1, 8, pa3);
#undef PK4
}
__device__ __forceinline__ void qkt(f32x16& p0, f32x16& p1, const char* Ks, const bf16x8* qr, int r32, int hi) {
  p0 = f32x16{}; p1 = f32x16{};
#pragma unroll
  for (int d0 = 0; d0 < 8; ++d0) { int cb = (d0 * 16 + hi * 8) * 2;
    bf16x8 b0 = *reinterpret_cast<const bf16x8*>(Ks + KSWZ(r32, cb));
    bf16x8 b1 = *reinterpret_cast<const bf16x8*>(Ks + KSWZ(32 + r32, cb));
    p0 = __builtin_amdgcn_mfma_f32_32x32x16_bf16(b0, qr[d0], p0, 0, 0, 0);
    p1 = __builtin_amdgcn_mfma_f32_32x32x16_bf16(b1, qr[d0], p1, 0, 0, 0); }
}
__device__ __forceinline__ int v_st(int k, int c) { const int kk = (k & ~0xC) | ((k & 4) << 1) | ((k & 8) >> 1); return ((kk >> 3) * 4 + (c >> 5)) * 512 + ((kk & 7) * 32 + (c & 31)) * 2; }
__device__ __forceinline__ int v_rd_base(int lane) { return ((lane & 3) << 3) | (((lane >> 2) & 3) << 6) | (((lane >> 4) & 1) << 5) | (((lane >> 5) & 1) << 8); }
constexpr int v_rd_off(int d0, int ks, int half) { return d0 * 512 + ks * 4096 + half * 2048; }
template <int OFF> __device__ __forceinline__ s16x4 tr_read(int vb) {
  s16x4 r; asm volatile("ds_read_b64_tr_b16 %0, %1 offset:%2" : "=&v"(r) : "v"(vb), "i"(OFF) : "memory"); return r;
}
template <int D0> __device__ __forceinline__ void pv_one(f32x16& od, int vb, bf16x8 pa0, bf16x8 pa1, bf16x8 pa2, bf16x8 pa3) {
  const s16x4 l0 = tr_read<v_rd_off(D0, 0, 0)>(vb), h0 = tr_read<v_rd_off(D0, 0, 1)>(vb), l1 = tr_read<v_rd_off(D0, 1, 0)>(vb), h1 = tr_read<v_rd_off(D0, 1, 1)>(vb);
  const s16x4 l2 = tr_read<v_rd_off(D0, 2, 0)>(vb), h2 = tr_read<v_rd_off(D0, 2, 1)>(vb), l3 = tr_read<v_rd_off(D0, 3, 0)>(vb), h3 = tr_read<v_rd_off(D0, 3, 1)>(vb);
  asm volatile("s_waitcnt lgkmcnt(0)" ::: "memory"); SBAR();
#define PK(L, H) (bf16x8){L[0], L[1], L[2], L[3], H[0], H[1], H[2], H[3]}
  od = __builtin_amdgcn_mfma_f32_32x32x16_bf16(pa0, PK(l0, h0), od, 0, 0, 0);
  od = __builtin_amdgcn_mfma_f32_32x32x16_bf16(pa1, PK(l1, h1), od, 0, 0, 0);
  od = __builtin_amdgcn_mfma_f32_32x32x16_bf16(pa2, PK(l2, h2), od, 0, 0, 0);
  od = __builtin_amdgcn_mfma_f32_32x32x16_bf16(pa3, PK(l3, h3), od, 0, 0, 0);
#undef PK
}
__device__ __forceinline__ void pv_d0(f32x16* o, int vb, bf16x8 pa0, bf16x8 pa1, bf16x8 pa2, bf16x8 pa3) {
  pv_one<0>(o[0], vb, pa0, pa1, pa2, pa3); pv_one<1>(o[1], vb, pa0, pa1, pa2, pa3); pv_one<2>(o[2], vb, pa0, pa1, pa2, pa3); pv_one<3>(o[3], vb, pa0, pa1, pa2, pa3);
}
__device__ __forceinline__ void body(const bf16_t* Qb, const bf16_t* __restrict__ Kh, const bf16_t* __restrict__ Vh, bf16_t* Ob, int seq, char* lds) {
  const int tid = threadIdx.x, wid = tid >> 6, lane = tid & 63, r32 = lane & 31, hi = lane >> 5;
  char* V_lds = lds; char* K_lds = lds + 2 * SHM_V;
  float* ws = (float*)(lds + 2 * SHM_V + 2 * SHM_K) + wid * 64; float* li_l = ws; float* al_l = ws + 32;
  float m_reg = -1e30f, l_reg = 0; f32x16 o[4] = {}; bf16x8 qr[8];
  const bf16_t* Qw = Qb + (long)(wid * QBLK + r32) * LDQ + hi * 8;
#pragma unroll
  for (int d0 = 0; d0 < 8; ++d0) qr[d0] = *reinterpret_cast<const bf16x8*>(Qw + d0 * 16);
  const int sr = tid >> 4, sc = (tid & 15) * 8, vst0 = v_st(sr, sc), vst1 = v_st(32 + sr, sc);
  const int vb0 = (int)(uintptr_t)V_lds + v_rd_base(lane);
  struct { bf16x8 vs0, vs1, ks0, ks1; } sr_[2];
#define SLOAD(i, k0) do { sr_[i].vs0 = *reinterpret_cast<const bf16x8*>(&Vh[(long)((k0) + sr) * LDK + sc]); sr_[i].vs1 = *reinterpret_cast<const bf16x8*>(&Vh[(long)((k0) + 32 + sr) * LDK + sc]); \
    sr_[i].ks0 = *reinterpret_cast<const bf16x8*>(&Kh[(long)((k0) + sr) * LDK + sc]); sr_[i].ks1 = *reinterpret_cast<const bf16x8*>(&Kh[(long)((k0) + 32 + sr) * LDK + sc]); } while (0)
#define SWRITE(b, i) do { *(bf16x8*)(V_lds + (b) * SHM_V + vst0) = sr_[i].vs0;          \
    *(bf16x8*)(V_lds + (b) * SHM_V + vst1) = sr_[i].vs1; int kc = sc * 2;               \
    *(bf16x8*)(K_lds + (b) * SHM_K + KSWZ(sr, kc)) = sr_[i].ks0;                       \
    *(bf16x8*)(K_lds + (b) * SHM_K + KSWZ(32 + sr, kc)) = sr_[i].ks1; } while (0)
#define SWAIT() asm volatile("s_waitcnt vmcnt(4)" ::: "memory")
#define RESC(a) do { if (__any((a) < 1.f)) { if (hi == 0) al_l[r32] = (a); asm volatile("s_waitcnt lgkmcnt(0)" ::: "memory"); \
    _Pragma("unroll") for (int d = 0; d < 4; ++d) _Pragma("unroll") for (int r = 0; r < 16; ++r) o[d][r] *= al_l[crow(r, hi)]; } } while (0)
  f32x16 pA0, pA1, pB0, pB1; float mnA, mnB, alA, alB; bf16x8 pa0, pa1, pa2, pa3; const int NT = seq / KVBLK;
  constexpr int SE = 0, SO = 1;
  SLOAD(SE, 0); asm volatile("s_waitcnt vmcnt(0)" ::: "memory"); SWRITE(0, SE); __syncthreads();
  qkt(pA0, pA1, K_lds, qr, r32, hi); partialSM(pA0, pA1, m_reg, mnA, alA);
  SLOAD(SO, KVBLK); if (2 < NT) SLOAD(SE, 2 * KVBLK);
  SWAIT(); SWRITE(1, SO); __syncthreads();
  for (int j = 1; j + 1 < NT; j += 2) {
    SBAR(); qkt(pB0, pB1, K_lds + SHM_K, qr, r32, hi);
    finishSM(pA0, pA1, alA, l_reg, pa0, pa1, pa2, pa3); SBAR();
    SLOAD(SO, (j + 2) * KVBLK); SBAR();
    pv_d0(o, vb0, pa0, pa1, pa2, pa3); partialSM(pB0, pB1, m_reg, mnB, alB);
    __syncthreads(); SWAIT(); SWRITE(0, SE);
    RESC(alB); __syncthreads();
    SBAR(); qkt(pA0, pA1, K_lds, qr, r32, hi);
    finishSM(pB0, pB1, alB, l_reg, pa0, pa1, pa2, pa3); SBAR();
    if (j + 3 < NT) SLOAD(SE, (j + 3) * KVBLK); SBAR();
    pv_d0(o, vb0 + (int)SHM_V, pa0, pa1, pa2, pa3); partialSM(pA0, pA1, m_reg, mnA, alA);
    __syncthreads(); SWAIT(); SWRITE(1, SO);
    RESC(alA); __syncthreads();
  }
  SBAR(); qkt(pB0, pB1, K_lds + SHM_K, qr, r32, hi);
  finishSM(pA0, pA1, alA, l_reg, pa0, pa1, pa2, pa3); SBAR();
  pv_d0(o, vb0, pa0, pa1, pa2, pa3); partialSM(pB0, pB1, m_reg, mnB, alB);
  __syncthreads(); RESC(alB);
  finishSM(pB0, pB1, alB, l_reg, pa0, pa1, pa2, pa3); SBAR();
  pv_d0(o, vb0 + (int)SHM_V, pa0, pa1, pa2, pa3);
  if (hi == 0) li_l[r32] = l_reg; asm volatile("s_waitcnt lgkmcnt(0)" ::: "memory");
  float rli[16];
#pragma unroll
  for (int r = 0; r < 16; ++r) rli[r] = __builtin_amdgcn_rcpf(li_l[crow(r, hi)]);
  bf16_t* Ow = Ob + (long)(wid * QBLK) * LDO;
#pragma unroll
  for (int r = 0; r < 16; ++r) { int orow = crow(r, hi);
#pragma unroll
    for (int d0 = 0; d0 < 4; ++d0) Ow[(long)orow * LDO + d0 * 32 + r32] = (bf16_t)f2bf(o[d0][r] * rli[r]); }
  __syncthreads();
#undef SLOAD
#undef SWRITE
#undef SWAIT
#undef RESC
}
#undef KSWZ
#undef SBAR
}

__device__ __forceinline__ void p4_mixers(Frame& F) {
    for (int u = blockIdx.x; u < NB * 8; u += F.G) ml::unit(F, u >> 3, u & 7);
#if defined(PROBE_SEL)
    if (blockIdx.x == 0 && F.tid == 0) ((volatile LAS unsigned long long*)(F.lds + MISC_OFF + 4096))[13] = __builtin_amdgcn_s_memrealtime();
#endif
    volatile LAS int* qslot = (volatile LAS int*)(F.lds + MISC_OFF + 64);
    bf16_t* AQ = (bf16_t*)(F.ws + WS_AQ); const bf16_t* AK = (const bf16_t*)(F.ws + WS_AK); const bf16_t* AV = (const bf16_t*)(F.ws + WS_AV);
    for (;;) {
        if (F.tid == 0) *qslot = (int)__hip_atomic_fetch_add((unsigned*)(F.ctl + CW_ATTQ), 1u, RLX_AGENT);
        __syncthreads();
        const int idx = *qslot;
        __syncthreads();
        if (idx >= NB * 8 * 8) break;
        const int b = idx >> 6, kvh = (idx >> 5) & 1, g = (idx >> 3) & 3, qb = idx & 7, head = kvh * 4 + g;
        bf16_t* Q = AQ + (size_t)(b * SEQ + qb * 256) * D + head * 128;
        const bf16_t* K = AK + (size_t)(b * KVL) * 256 + kvh * 128; const bf16_t* V = AV + (size_t)(b * KVL) * 256 + kvh * 128;
        at::body(Q, K, V, Q, KVL, (char*)F.lds);
    }
}

struct RectOrder { static constexpr bool GATHER = false; const char* A; const char* A2; const char* Bt; int nM, nN, K, lda, G, c;
    __device__ __forceinline__ bool next(int i, pg8::Unit& u) const { const long L = (long)i * G + c; if (L >= nM * nN) return false; pg8::tile_of((int)L, nM, nN, u.pm, u.pn); u.x0 = 0; u.x1 = 0; return true; }
    __device__ __forceinline__ const char* aptr(const pg8::Unit& u) const { return A + (size_t)u.pm * 256 * lda * 2; }
    __device__ __forceinline__ const char* aptr2(const pg8::Unit& u) const { return A2 + (size_t)u.pm * 256 * lda * 2; }
    __device__ __forceinline__ const char* bptr(const pg8::Unit& u) const { return Bt + (size_t)u.pn * 256 * K * 2; }
    __device__ __forceinline__ void aoff(const pg8::Unit&, int, unsigned (&)[2][2]) const {}
};
struct EpiMerge { static constexpr bool PERM = true; const bf16_t* mg; bf16_t* Z;
    __device__ __forceinline__ void mid(f32x4 (&acc)[2][2][4][2], const pg8::Unit& u, int wr, int wc, int fr, int fq) const {
        const int row0 = u.pm * 256 + wr * 64 + fr, col0 = u.pn * 256 + wc * 32 + 8 * fq;
#pragma unroll
        for (int ai = 0; ai < 2; ++ai)
#pragma unroll
            for (int m = 0; m < 4; ++m) { const size_t row = (size_t)(row0 + ai * 128 + m * 16);
#pragma unroll
                for (int bj = 0; bj < 2; ++bj) { const int col = col0 + bj * 128;
                    const u32x4 g0 = *(const GAS u32x4*)(mg + row * (2 * D) + col), g1 = *(const GAS u32x4*)(mg + row * (2 * D) + D + col);
                    const unsigned a[4] = {g0.x, g0.y, g0.z, g0.w}, b[4] = {g1.x, g1.y, g1.z, g1.w};
#pragma unroll
                    for (int j = 0; j < 4; ++j) { const float r0 = (1.0f + __expf(-bflo(b[j]))) / (1.0f + __expf(-bflo(a[j]))), r1 = (1.0f + __expf(-bfhi(b[j]))) / (1.0f + __expf(-bfhi(a[j])));
                        acc[ai][bj][m][j >> 1][(2 * j) & 3] *= r0; acc[ai][bj][m][j >> 1][(2 * j + 1) & 3] *= r1; } }
                asm volatile("" ::: "memory"); }
    }
    __device__ __forceinline__ void operator()(const f32x4 (&acc)[2][2][4][2], const pg8::Unit& u, int wr, int wc, int fr, int fq) const {
        const int row0 = u.pm * 256 + wr * 64 + fr, col0 = u.pn * 256 + wc * 32 + 8 * fq;
#pragma unroll
        for (int ai = 0; ai < 2; ++ai)
#pragma unroll
            for (int m = 0; m < 4; ++m) { const size_t row = (size_t)(row0 + ai * 128 + m * 16);
#pragma unroll
                for (int bj = 0; bj < 2; ++bj) { const int col = col0 + bj * 128;
                    const u32x4 gw = *(const GAS u32x4*)(mg + row * (2 * D) + D + col);
                    const f32x4 v0 = acc[ai][bj][m][0], v1 = acc[ai][bj][m][1];
                    u32x4 w; w.x = cvt_pk_bf16(sigmoidf_(bflo(gw.x)) * v0[0], sigmoidf_(bfhi(gw.x)) * v0[1]); w.y = cvt_pk_bf16(sigmoidf_(bflo(gw.y)) * v0[2], sigmoidf_(bfhi(gw.y)) * v0[3]);
                    w.z = cvt_pk_bf16(sigmoidf_(bflo(gw.z)) * v1[0], sigmoidf_(bfhi(gw.z)) * v1[1]); w.w = cvt_pk_bf16(sigmoidf_(bflo(gw.w)) * v1[2], sigmoidf_(bfhi(gw.w)) * v1[3]);
                    *(GAS u32x4*)(Z + row * D + col) = w; }
                asm volatile("" ::: "memory"); }
    }
};
struct EpiOut { static constexpr bool PERM = false; const float* x; const float* mod; float* out;
    __device__ __forceinline__ void operator()(const f32x4 (&acc)[2][2][4][2], const pg8::Unit& u, int wr, int wc, int fr, int fq) const {
        const int row0 = u.pm * 256 + wr * 64 + fr, col0 = u.pn * 256 + wc * 32 + 4 * fq; const float* g1 = mod + (size_t)((u.pm * 256) / SEQ) * NMOD + 2 * D;
#pragma unroll
        for (int ai = 0; ai < 2; ++ai)
#pragma unroll
            for (int m = 0; m < 4; ++m) { const size_t ro = (size_t)(row0 + ai * 128 + m * 16) * D;
#pragma unroll
                for (int bj = 0; bj < 2; ++bj)
#pragma unroll
                    for (int n = 0; n < 2; ++n) { const int col = col0 + bj * 128 + n * 16;
                        const f32x4 xv = *(const GAS f32x4*)(x + ro + col), gv = *(const f32x4*)(g1 + col);
                        *(GAS f32x4*)(out + ro + col) = xv + gv * acc[ai][bj][m][n]; }
                asm volatile("" ::: "memory"); }
    }
};

struct DrGU { int up; __device__ __forceinline__ int operator()(int j) const { return 256 * (j >> 7) + 128 * ((j >> 6) & 1) + 32 * ((j >> 4) & 3) + 8 * ((j >> 2) & 3) + 4 * up + (j & 3); } };
__device__ __forceinline__ void p6_fl(Frame& F) {
    const int gw = F.vcu * NWAVES + F.wave, NGW = F.G * NWAVES;
    {
        LAS float* scr = (LAS float*)(F.lds + F.wave * 16384);
        bf16_t* wgu = (bf16_t*)(F.ws + WS_WGU); bf16_t* wd = (bf16_t*)(F.ws + WS_WD);
        constexpr int I_G = 16 * 8, I_D = 4 * 32, PER_E = 2 * I_G + I_D;
        for (int it = gw; it < NEXP * PER_E; it += NGW) { const int e = it / PER_E; int r = it % PER_E;
            if (r < I_G) { transpose_item(F.in[IN_WEG] + (size_t)e * D * DEXP, D, DEXP, wgu + (size_t)e * 512 * D, DrGU{0}, scr, r, F.lane); continue; } r -= I_G;
            if (r < I_G) { transpose_item(F.in[IN_WEU] + (size_t)e * D * DEXP, D, DEXP, wgu + (size_t)e * 512 * D, DrGU{1}, scr, r, F.lane); continue; } r -= I_G;
            transpose_item(F.in[IN_WED] + (size_t)e * DEXP * D, DEXP, D, wd + (size_t)e * D * DEXP, DrIdent{0}, scr, r, F.lane); }
    }
    const float* mod = (const float*)(F.ws + WS_MOD); const float* n2w = F.in[IN_N2W]; bf16_t* FL = (bf16_t*)(F.ws + WS_FL);
    constexpr int RB = 4;
    for (int row0 = gw; row0 < T_LAT; row0 += RB * NGW) {
        f32x4 v[RB][4];
#pragma unroll
        for (int q = 0; q < RB; ++q) { const int row = row0 + q * NGW; if (row < T_LAT) { const GAS f32x4* hr = (const GAS f32x4*)(F.out + (size_t)row * D) + F.lane;
#pragma unroll
            for (int j = 0; j < 4; ++j) v[q][j] = hr[64 * j]; } }
#pragma unroll
        for (int q = 0; q < RB; ++q) { const int row = row0 + q * NGW; if (row < T_LAT) {
            const int b = row / SEQ; float s = 0.f;
#pragma unroll
            for (int j = 0; j < 4; ++j) s += (v[q][j].x * v[q][j].x + v[q][j].y * v[q][j].y) + (v[q][j].z * v[q][j].z + v[q][j].w * v[q][j].w);
            const float rinv = 1.0f / sqrtf(wave_sum(s) * (1.0f / D) + EPS);
            GAS u32x2* o8 = (GAS u32x2*)(FL + (size_t)row * D) + F.lane;
#pragma unroll
            for (int j = 0; j < 4; ++j) { const int col = 256 * j + 4 * F.lane;
                const f32x4 w = *(const f32x4*)(n2w + col), sh = *(const f32x4*)(mod + b * NMOD + 3 * D + col), sc = *(const f32x4*)(mod + b * NMOD + 4 * D + col);
                const f32x4 y = (v[q][j] * rinv) * w * (sc + 1.0f) + sh;
                u32x2 o; o.x = cvt_pk_bf16(y.x, y.y); o.y = cvt_pk_bf16(y.z, y.w); o8[64 * j] = o; } } }
    }
}
struct EpiLogits { static constexpr bool PERM = false; float* LG;
    __device__ __forceinline__ void operator()(const f32x4 (&acc)[2][2][4][2], const pg8::Unit& u, int wr, int wc, int fr, int fq) const {
        const int row0 = u.pm * 256 + wr * 64 + fr, col0 = wc * 32 + 4 * fq;
#pragma unroll
        for (int ai = 0; ai < 2; ++ai)
#pragma unroll
            for (int m = 0; m < 4; ++m) { float* p = LG + (size_t)(row0 + ai * 128 + m * 16) * 128 + col0;
                *(GAS f32x4*)p = acc[ai][0][m][0]; *(GAS f32x4*)(p + 16) = acc[ai][0][m][1]; }
    }
};
__device__ __forceinline__ void p8_route(Frame& F) {
    const float* LG = (const float*)(F.ws + WS_LG); const float* brg = F.in[IN_BRG]; const float* bre = F.in[IN_BRE];
    unsigned* eid = (unsigned*)(F.ws + WS_ROUT); unsigned* yi = eid + 2 * T_LAT; unsigned* lists = (unsigned*)(F.ws + WS_LISTS); float* lw = (float*)(F.ws + WS_LW);
    for (int row = blockIdx.x * NTHREADS + F.tid; row < T_LAT; row += F.G * NTHREADS) {
        const float* lp = LG + (size_t)row * 128;
        const f32x4 gh = *(const GAS f32x4*)lp, gl4 = *(const GAS f32x4*)(lp + 64);
        float gl[4] = {gh.x + gl4.x + brg[0], gh.y + gl4.y + brg[1], gh.z + gl4.z + brg[2], gh.w + gl4.w + brg[3]};
        int gs = 0; float gm = gl[0];
#pragma unroll
        for (int g = 1; g < 4; ++g) if (gl[g] > gm) { gm = gl[g]; gs = g; }
        float den = 0.f;
#pragma unroll
        for (int g = 0; g < 4; ++g) den += expf(gl[g] - gm);
        const float pgrp = 1.0f / den;
        const f32x4 h0 = *(const GAS f32x4*)(lp + 4 + 8 * gs), h1 = *(const GAS f32x4*)(lp + 8 + 8 * gs), l0 = *(const GAS f32x4*)(lp + 68 + 8 * gs), l1 = *(const GAS f32x4*)(lp + 72 + 8 * gs);
        const f32x4 b0 = *(const f32x4*)(bre + 8 * gs), b1 = *(const f32x4*)(bre + 8 * gs + 4);
        const float el[8] = {h0.x + l0.x + b0.x, h0.y + l0.y + b0.y, h0.z + l0.z + b0.z, h0.w + l0.w + b0.w, h1.x + l1.x + b1.x, h1.y + l1.y + b1.y, h1.z + l1.z + b1.z, h1.w + l1.w + b1.w};
        int i0 = 0; float v0 = el[0];
#pragma unroll
        for (int j = 1; j < 8; ++j) if (el[j] > v0) { v0 = el[j]; i0 = j; }
        int i1 = -1; float v1 = -3.0e38f;
#pragma unroll
        for (int j = 0; j < 8; ++j) if (j != i0 && el[j] > v1) { v1 = el[j]; i1 = j; }
        const float e1 = expf(v1 - v0), w0 = pgrp / (1.0f + e1), w1 = pgrp * e1 / (1.0f + e1);
        const int ex0 = gs * 8 + i0, ex1 = gs * 8 + i1;
        const unsigned p0 = __hip_atomic_fetch_add((unsigned*)(F.ctl + CW_CNT + ex0 * 64), 1u, RLX_AGENT);
        const unsigned p1 = __hip_atomic_fetch_add((unsigned*)(F.ctl + CW_CNT + (32 + ex1) * 64), 1u, RLX_AGENT);
        lists[(size_t)ex0 * T_LAT + p0] = (unsigned)row; lists[(size_t)(32 + ex1) * T_LAT + p1] = (unsigned)row;
        lw[(size_t)ex0 * T_LAT + p0] = w0; lw[(size_t)(32 + ex1) * T_LAT + p1] = w1;
        eid[row] = (unsigned)ex0; eid[T_LAT + row] = (unsigned)(32 + ex1); yi[row] = p0; yi[T_LAT + row] = p1;
    }
}

__device__ __forceinline__ void moe_table(Frame& F) {
    volatile LAS int* ts = (volatile LAS int*)(F.lds + MISC_OFF + 256); volatile LAS int* cn = ts + 80;
    if (F.tid < 64) cn[F.tid] = (int)__hip_atomic_load((unsigned*)(F.ctl + CW_CNT + F.tid * 64), RLX_AGENT);
    __syncthreads();
    if (F.tid == 0) { int a = 0, c = 0; volatile LAS int* cs = cn + 64; for (int g = 0; g < 64; ++g) { ts[g] = a; a += (cn[g] + 255) >> 8; cs[g] = c; c += cn[g]; } ts[64] = a; }
    __syncthreads();
}
struct Moe1Order { static constexpr bool GATHER = true; const char* FLb; const char* Wgu; const unsigned* lists; const LAS int* ts; const LAS int* cn; int G, c;
    __device__ __forceinline__ bool next(int i, pg8::Unit& u) const { const long L = (long)i * G + c; const int T = (int)(L >> 1); if (T >= ts[64]) return false;
        int g = 0; while (ts[g + 1] <= T) ++g;
        u.pm = T; u.pn = (int)(L & 1); u.x0 = g; u.x1 = (T - ts[g]) * 256; return true; }
    __device__ __forceinline__ const char* aptr(const pg8::Unit&) const { return FLb; }
    __device__ __forceinline__ const char* bptr(const pg8::Unit& u) const { return Wgu + ((size_t)(u.x0 & 31) * 512 + (size_t)u.pn * 256) * D * 2; }
    __device__ __forceinline__ void aoff(const pg8::Unit& u, int tid, unsigned (&off)[2][2]) const { const int n = cn[u.x0];
#pragma unroll
        for (int i = 0; i < 2; ++i) { int R, C; pg8::stage_rc(tid * 16 + i * 8192, R, C);
#pragma unroll
            for (int h = 0; h < 2; ++h) { const int idx = u.x1 + h * 128 + R; const unsigned tok = idx < n ? lists[(size_t)u.x0 * T_LAT + idx] : 0u; off[h][i] = tok * (unsigned)(D * 2) + (unsigned)(C * 2); } } }
};
struct EpiMoe1 { static constexpr bool PERM = true; bf16_t* H;
    __device__ __forceinline__ void operator()(const f32x4 (&acc)[2][2][4][2], const pg8::Unit& u, int wr, int wc, int fr, int fq) const {
        const int row0 = u.pm * 256 + wr * 64 + fr, col0 = u.pn * 128 + 16 * wc + 4 * fq;
#pragma unroll
        for (int ai = 0; ai < 2; ++ai)
#pragma unroll
            for (int m = 0; m < 4; ++m)
#pragma unroll
                for (int bj = 0; bj < 2; ++bj) { const f32x4 g = acc[ai][bj][m][0], up = acc[ai][bj][m][1];
                    u32x2 w; w.x = cvt_pk_bf16(siluf_(g[0]) * up[0], siluf_(g[1]) * up[1]); w.y = cvt_pk_bf16(siluf_(g[2]) * up[2], siluf_(g[3]) * up[3]);
                    *(GAS u32x2*)(H + (size_t)(row0 + ai * 128 + m * 16) * DEXP + col0 + 64 * bj) = w; }
    }
};
struct Moe2Order { static constexpr bool GATHER = false; const char* Hb; const char* Wd; const LAS int* ts; int G, c;
    __device__ __forceinline__ bool next(int i, pg8::Unit& u) const { const long L = (long)i * G + c; const int T = (int)(L >> 2); if (T >= ts[64]) return false;
        int g = 0; while (ts[g + 1] <= T) ++g;
        u.pm = T; u.pn = (int)(L & 3); u.x0 = g; u.x1 = (T - ts[g]) * 256; return true; }
    __device__ __forceinline__ const char* aptr(const pg8::Unit& u) const { return Hb + (size_t)u.pm * 256 * DEXP * 2; }
    __device__ __forceinline__ const char* bptr(const pg8::Unit& u) const { return Wd + ((size_t)(u.x0 & 31) * D + (size_t)u.pn * 256) * DEXP * 2; }
    __device__ __forceinline__ void aoff(const pg8::Unit&, int, unsigned (&)[2][2]) const {}
};
struct EpiMoe2 { static constexpr bool PERM = true; bf16_t* Y; const float* lw; const LAS int* cn;
    __device__ __forceinline__ void operator()(const f32x4 (&acc)[2][2][4][2], const pg8::Unit& u, int wr, int wc, int fr, int fq) const {
        const int n = cn[u.x0], cs = cn[64 + u.x0], col0 = u.pn * 256 + wc * 32 + 8 * fq;
#pragma unroll
        for (int ai = 0; ai < 2; ++ai)
#pragma unroll
            for (int m = 0; m < 4; ++m) { const int idx = u.x1 + ai * 128 + wr * 64 + m * 16 + fr;
                if (idx < n) { const float w = lw[(size_t)u.x0 * T_LAT + idx]; bf16_t* yp = Y + (size_t)(cs + idx) * D + col0;
#pragma unroll
                    for (int bj = 0; bj < 2; ++bj) { const f32x4 v0 = acc[ai][bj][m][0] * w, v1 = acc[ai][bj][m][1] * w;
                        u32x4 o; o.x = cvt_pk_bf16(v0[0], v0[1]); o.y = cvt_pk_bf16(v0[2], v0[3]); o.z = cvt_pk_bf16(v1[0], v1[1]); o.w = cvt_pk_bf16(v1[2], v1[3]);
                        *(GAS u32x4*)(yp + bj * 128) = o; } }
                asm volatile("" ::: "memory"); }
    }
};
__device__ __forceinline__ void p11_combine(Frame& F) {
    const int gw = F.vcu * NWAVES + F.wave, NGW = F.G * NWAVES;
    const LAS int* cs = (const LAS int*)(F.lds + MISC_OFF + 256) + 80 + 64;
    const unsigned* eid = (const unsigned*)(F.ws + WS_ROUT); const unsigned* yi = eid + 2 * T_LAT; const bf16_t* Y = (const bf16_t*)(F.ws + WS_Y); const float* mod = (const float*)(F.ws + WS_MOD);
    for (int row = gw; row < T_LAT; row += NGW) {
        const unsigned r0 = (unsigned)cs[eid[row]] + yi[row], r1 = (unsigned)cs[eid[T_LAT + row]] + yi[T_LAT + row];
        const float* g2 = mod + (size_t)(row / SEQ) * NMOD + 5 * D; float* op = F.out + (size_t)row * D;
#pragma unroll
        for (int hf = 0; hf < 2; ++hf) { const int col = hf * 512 + 8 * F.lane;
            const u32x4 a = *(const GAS u32x4*)(Y + (size_t)r0 * D + col), b = *(const GAS u32x4*)(Y + (size_t)r1 * D + col);
            const f32x4 ga = *(const f32x4*)(g2 + col), gb = *(const f32x4*)(g2 + col + 4); f32x4 oa = *(const GAS f32x4*)(op + col), ob = *(const GAS f32x4*)(op + col + 4);
            oa.x += ga.x * (bflo(a.x) + bflo(b.x)); oa.y += ga.y * (bfhi(a.x) + bfhi(b.x)); oa.z += ga.z * (bflo(a.y) + bflo(b.y)); oa.w += ga.w * (bfhi(a.y) + bfhi(b.y));
            ob.x += gb.x * (bflo(a.z) + bflo(b.z)); ob.y += gb.y * (bfhi(a.z) + bfhi(b.z)); ob.z += gb.z * (bflo(a.w) + bflo(b.w)); ob.w += gb.w * (bfhi(a.w) + bfhi(b.w));
            *(GAS f32x4*)(op + col) = oa; *(GAS f32x4*)(op + col + 4) = ob; }
    }
}

#ifndef MK_N_LAUNCHES
#define MK_N_LAUNCHES 1
#endif
constexpr int N_PHASES = 12;
constexpr int N_LAUNCHES = MK_N_LAUNCHES;
struct Args { const float* in[23]; float* out; unsigned char* ws; int ph_lo, ph_hi, kd, pad; };
__global__ void __launch_bounds__(NTHREADS, 2) fwd_kernel(Args args) {
    extern __shared__ __attribute__((aligned(16))) unsigned char lds[];
    Frame F;
    F.lds = (LAS unsigned char*)lds;
    F.tid = threadIdx.x; F.lane = F.tid & 63; F.wave = __builtin_amdgcn_readfirstlane(F.tid >> 6);
    F.G = gridDim.x; { const int bx = blockIdx.x; F.vcu = (F.G % 8 == 0) ? (bx % 8) * (F.G / 8) + bx / 8 : bx; }
    F.ws = args.ws; F.out = args.out; F.ctl = (gu32*)(args.ws + WS_CTL);
#pragma unroll
    for (int i = 0; i < 23; ++i) F.in[i] = args.in[i];
    for (int u = F.tid; u < (LDS_BYTES - MISC_OFF) / 4; u += NTHREADS) ((LAS unsigned*)(F.lds + MISC_OFF))[u] = 0u;
    __syncthreads();
    XcdBarrier bar; bar.bar = (unsigned*)(F.ctl + CW_BAR); bar.x = 0; bar.st = nullptr;
    if (N_LAUNCHES == 1) bar = xcd_barrier_post((unsigned*)(F.ctl + CW_BAR), (volatile LAS unsigned*)(F.lds + MISC_OFF + 32));
    const int lo = args.ph_lo, hi = args.ph_hi;
#ifndef PH_MASK
#define PH_MASK 0xFFF
#endif
#define IN(k) ((((PH_MASK) >> (k)) & 1) && lo <= (k) && (k) < hi)
#define SEAM(k) do { if (IN(k) && IN((k) + 1)) xcd_barrier(bar); STAMP((k) + 1); } while (0)
#if defined(PROBE_SEL)
#define STAMP(k) do { if (blockIdx.x == 0 && F.tid == 0) ((volatile LAS unsigned long long*)(F.lds + MISC_OFF + 4096))[k] = __builtin_amdgcn_s_memrealtime(); } while (0)
#else
#define STAMP(k) do { } while (0)
#endif
    STAMP(0);

    if (IN(0)) { p0_prologue(F); } SEAM(0);
    if (IN(1)) { p1_a0(F); } SEAM(1);
    if (IN(2)) {
        InProjOrder S{(const char*)(F.ws + WS_A0), (const char*)(F.ws + WS_WIN), F.G, (int)blockIdx.x};
        EpiInProj E{F.ws, (bf16_t*)F.out, F.in[IN_BMG], F.in[IN_QNW], F.in[IN_KNW], F.lds};
        pg8::gemm_phase<EpiInProj, InProjOrder, true>(F.lds, D, S, E);
    } SEAM(2);
    if (IN(3)) { p4_mixers(F); } SEAM(3);
    if (IN(4)) {
        RectOrder S{(const char*)(F.ws + WS_MQ), (const char*)(F.ws + WS_AQ), (const char*)(F.ws + WS_WBM), MT_LAT, 4, 2 * D, D, F.G, (int)blockIdx.x};
        EpiMerge E{(const bf16_t*)F.out, (bf16_t*)(F.ws + WS_Z)};
        pg8::gemm_phase<EpiMerge, RectOrder, true, true>(F.lds, 2 * D, S, E);
    } SEAM(4);
    if (IN(5)) {
        RectOrder S{(const char*)(F.ws + WS_Z), nullptr, (const char*)(F.ws + WS_WO), MT_LAT, 4, D, D, F.G, (int)blockIdx.x};
        EpiOut E{F.in[IN_X], (const float*)(F.ws + WS_MOD), F.out};
        pg8::gemm_phase<EpiOut, RectOrder, true>(F.lds, D, S, E);
    } SEAM(5);
    if (IN(6)) { p6_fl(F); } SEAM(6);
    if (IN(7)) {
        RectOrder S{(const char*)(F.ws + WS_FL), nullptr, (const char*)(F.ws + WS_WR), MT_LAT, 1, D, D, F.G, (int)blockIdx.x};
        EpiLogits E{(float*)(F.ws + WS_LG)};
        pg8::gemm_phase<EpiLogits, RectOrder, true>(F.lds, D, S, E);
    } SEAM(7);
    if (IN(8)) { p8_route(F); } SEAM(8);
    if (IN(9)) {
        moe_table(F);
        const LAS int* ts = (const LAS int*)(F.lds + MISC_OFF + 256);
        Moe1Order S{(const char*)(F.ws + WS_FL), (const char*)(F.ws + WS_WGU), (const unsigned*)(F.ws + WS_LISTS), ts, ts + 80, F.G, (int)blockIdx.x};
        EpiMoe1 E{(bf16_t*)(F.ws + WS_H)};
        pg8::gemm_phase<EpiMoe1, Moe1Order, true>(F.lds, D, S, E);
    } SEAM(9);
    if (IN(10)) {
        moe_table(F);
        const LAS int* ts = (const LAS int*)(F.lds + MISC_OFF + 256);
        Moe2Order S{(const char*)(F.ws + WS_H), (const char*)(F.ws + WS_WD), ts, F.G, (int)blockIdx.x};
        EpiMoe2 E{(bf16_t*)(F.ws + WS_Y), (const float*)(F.ws + WS_LW), ts + 80};
        pg8::gemm_phase<EpiMoe2, Moe2Order, true>(F.lds, args.kd, S, E);
    } SEAM(10);
    if (IN(11)) { moe_table(F); p11_combine(F); }
#if defined(PROBE_SEL)
    STAMP(12);
    if (blockIdx.x == 0 && F.tid == 0) { volatile LAS unsigned long long* ts = (volatile LAS unsigned long long*)(F.lds + MISC_OFF + 4096);
        const unsigned long long dt = (PROBE_SEL >= 14 ? ts[PROBE_SEL] : PROBE_SEL == 13 ? ts[13] - ts[3] : ts[PROBE_SEL + 1] - ts[PROBE_SEL]) * PROBE_MULT; const unsigned long long t0 = __builtin_amdgcn_s_memrealtime();
        while (__builtin_amdgcn_s_memrealtime() - t0 < dt) __builtin_amdgcn_s_sleep(8); }
#endif
#undef IN
#undef SEAM
}

extern "C" void kernel_launch(void* const* d_in, const int* in_sizes, int n_in, void* d_out, int out_size, void* d_ws, size_t ws_size, hipStream_t stream) {
    static int grid = 0;
    if (grid == 0) {
        if (n_in != 23 || out_size != T_LAT * D || ws_size < WS_END) { fprintf(stderr, "kernel_launch: unexpected shapes (n_in %d out %d ws %zu)\n", n_in, out_size, ws_size); grid = -1; return; }
        int dev = 0, cus = 0;
        if (hipGetDevice(&dev) != hipSuccess || hipDeviceGetAttribute(&cus, hipDeviceAttributeMultiprocessorCount, dev) != hipSuccess) { grid = -1; return; }
        if (hipFuncSetAttribute((const void*)fwd_kernel, hipFuncAttributeMaxDynamicSharedMemorySize, LDS_BYTES) != hipSuccess) { fprintf(stderr, "kernel_launch: hipFuncSetAttribute failed\n"); grid = -1; return; }
        int per_cu = 0;
        if (hipOccupancyMaxActiveBlocksPerMultiprocessor(&per_cu, (const void*)fwd_kernel, NTHREADS, LDS_BYTES) != hipSuccess || per_cu < 1) fprintf(stderr, "kernel_launch: occupancy query says %d\n", per_cu);
        (void)hipGetLastError();
        grid = cus;
    }
    if (grid < 0) return;
    if (hipMemsetAsync((char*)d_ws + WS_CTL, 0, CTL_ZERO_BYTES, stream) != hipSuccess) return;
    Args a{};
    for (int i = 0; i < 23; ++i) a.in[i] = (const float*)d_in[i];
    a.out = (float*)d_out; a.ws = (unsigned char*)d_ws; a.kd = DEXP; a.pad = 0;
    if (N_LAUNCHES == 1) { a.ph_lo = 0; a.ph_hi = N_PHASES; hipLaunchKernelGGL(fwd_kernel, dim3(grid), dim3(NTHREADS), LDS_BYTES, stream, a); }
    else for (int p = 0; p < N_PHASES; ++p) { a.ph_lo = p; a.ph_hi = p + 1; hipLaunchKernelGGL(fwd_kernel, dim3(grid), dim3(NTHREADS), LDS_BYTES, stream, a); }
    const hipError_t le = hipPeekAtLastError();
    if (le != hipSuccess) fprintf(stderr, "kernel_launch: launch failed: %s\n", hipGetErrorName(le));
}
```
